# Optimizing an MI355X kernel written in HIP

```python
import math
import jax
import jax.numpy as jnp
from jax import lax
import numpy as np

D_MODEL = 2048
BATCH = 16
SEQ = 2048
DEPTH = 2

BRANCH_WIDTH = 1024
N_BRANCH = 3
M_HEADS = 4
M_HEAD_DIM = BRANCH_WIDTH // M_HEADS
M_WIDTH = M_HEADS * M_HEAD_DIM
M_CONV = 4
M_CHUNK = 64
DA_HEADS = 4
DA_HEAD_DIM = 128
DA_V_DIM = 2 * DA_HEAD_DIM
DA_QK_WIDTH = DA_HEADS * 2 * DA_HEAD_DIM
DA_WIDTH = DA_HEADS * DA_V_DIM
Q_BLOCK = 128
REL_BUCKETS = 32
REL_MAX_DIST = 128
S5_WIDTH = BRANCH_WIDTH
S5_GROUP = 16
S5_GROUPS = S5_WIDTH // S5_GROUP
S5_STATE = 64
D_FF = 5632
FFN_CONV = 3
EPS = 1e-6
IN_SIZES = (M_WIDTH, M_WIDTH, M_WIDTH, M_WIDTH, M_HEADS, M_HEADS,
            DA_QK_WIDTH, DA_QK_WIDTH, DA_WIDTH, S5_WIDTH, N_BRANCH * D_MODEL)
N_IN = sum(IN_SIZES)

kernel_name = 'hybrid_gated_mlstm_diffattn_s5'


def rmsnorm(x, gain):
    xf = x.astype(jnp.float32)
    var = jnp.mean(xf * xf, axis=-1, keepdims=True)
    return (xf * lax.rsqrt(var + EPS) * gain.astype(jnp.float32)).astype(x.dtype)


def causal_dwconv(x, w):
    K = w.shape[0]
    L = x.shape[1]
    xp = jnp.pad(x, ((0, 0), (K - 1, 0), (0, 0)))
    return sum(w[j] * xp[:, j:j + L] for j in range(K))


def t5_causal_bucket(dist):
    n = jnp.maximum(dist, 0)
    max_exact = REL_BUCKETS // 2
    nf = jnp.maximum(n, 1).astype(jnp.float32)
    large = max_exact + (jnp.log(nf / max_exact) / math.log(REL_MAX_DIST / max_exact)
                         * (REL_BUCKETS - max_exact)).astype(jnp.int32)
    large = jnp.minimum(large, REL_BUCKETS - 1)
    return jnp.where(n < max_exact, n, large)


def mlstm_branch(q, k, v, o, i_pre, f_pre, conv_w, norm_g):
    dtype = v.dtype
    B, L, _ = q.shape
    nc = L // M_CHUNK
    qk = jax.nn.silu(causal_dwconv(jnp.concatenate([q, k], axis=-1), conv_w))
    q, k = jnp.split(qk, 2, axis=-1)

    def to_chunks(t):
        return t.astype(jnp.float32).reshape(B, nc, M_CHUNK, M_HEADS, -1).transpose(1, 0, 3, 2, 4)

    def gate_chunks(t):
        return t.astype(jnp.float32).reshape(B, nc, M_CHUNK, M_HEADS).transpose(1, 0, 3, 2)

    qc = to_chunks(q)
    kc = to_chunks(k) * (M_HEAD_DIM ** -0.5)
    vc = to_chunks(v)
    log_i = gate_chunks(i_pre)
    log_f = jax.nn.log_sigmoid(gate_chunks(f_pre))
    causal = jnp.tril(jnp.ones((M_CHUNK, M_CHUNK), dtype=bool))

    def step(carry, inp):
        C, n, m = carry
        qt, kt, vt, li, lf = inp
        b = jnp.cumsum(lf, axis=-1)
        g = b[..., -1]
        dmat = b[..., :, None] - b[..., None, :] + li[..., None, :]
        dmat = jnp.where(causal, dmat, -jnp.inf)
        inter = b + m[..., None]
        m_t = jnp.maximum(inter, jnp.max(dmat, axis=-1))
        s = jnp.einsum('bhtd,bhsd->bhts', qt, kt) * jnp.exp(dmat - m_t[..., None])
        w_inter = jnp.exp(inter - m_t)
        num = (jnp.einsum('bhts,bhsv->bhtv', s, vt)
               + w_inter[..., None] * jnp.einsum('bhtd,bhdv->bhtv', qt, C))
        den = jnp.sum(s, axis=-1) + w_inter * jnp.einsum('bhtd,bhd->bht', qt, n)
        h = num / jnp.maximum(jnp.abs(den), jnp.exp(-m_t))[..., None]
        a_s = g[..., None] - b + li
        m_new = jnp.maximum(g + m, jnp.max(a_s, axis=-1))
        ws = jnp.exp(a_s - m_new[..., None])
        decay = jnp.exp(g + m - m_new)
        C_new = decay[..., None, None] * C + jnp.einsum('bhs,bhsd,bhsv->bhdv', ws, kt, vt)
        n_new = decay[..., None] * n + jnp.einsum('bhs,bhsd->bhd', ws, kt)
        return (C_new, n_new, m_new), h

    init = (jnp.zeros((B, M_HEADS, M_HEAD_DIM, M_HEAD_DIM), jnp.float32),
            jnp.zeros((B, M_HEADS, M_HEAD_DIM), jnp.float32),
            jnp.zeros((B, M_HEADS), jnp.float32))
    _, h = lax.scan(step, init, (qc, kc, vc, log_i, log_f))
    h = h.transpose(1, 0, 3, 2, 4).reshape(B, L, M_HEADS, M_HEAD_DIM)
    h = rmsnorm(h, norm_g.reshape(M_HEADS, M_HEAD_DIM)).reshape(B, L, M_WIDTH)
    return (jax.nn.sigmoid(o.astype(jnp.float32)) * h).astype(dtype)


def diff_attention_branch(q, k, v, lam, norm_g, rel_bias, lambda_init):
    dtype = v.dtype
    B, L, _ = q.shape
    nb = L // Q_BLOCK
    q = q.astype(jnp.float32).reshape(B, L, DA_HEADS, 2, DA_HEAD_DIM) * (DA_HEAD_DIM ** -0.5)
    k = k.astype(jnp.float32).reshape(B, L, DA_HEADS, 2, DA_HEAD_DIM)
    v = v.astype(jnp.float32).reshape(B, L, DA_HEADS, DA_V_DIM)
    lam = lam.astype(jnp.float32)
    lam_full = jnp.exp(jnp.sum(lam[0] * lam[1])) - jnp.exp(jnp.sum(lam[2] * lam[3])) + lambda_init
    bias_table = rel_bias.astype(jnp.float32)
    qb = q.reshape(B, nb, Q_BLOCK, DA_HEADS, 2, DA_HEAD_DIM).transpose(1, 0, 2, 3, 4, 5)
    k_pos = jnp.arange(L)

    def block(args):
        qblk, start = args
        q_pos = start + jnp.arange(Q_BLOCK)
        dist = q_pos[:, None] - k_pos[None, :]
        bias = jnp.transpose(bias_table[t5_causal_bucket(dist)], (2, 0, 1))
        logits = jnp.einsum('bqhmd,bkhmd->bhmqk', qblk, k) + bias[None, :, None]
        logits = jnp.where(dist >= 0, logits, -jnp.inf)
        p = jax.nn.softmax(logits, axis=-1)
        attn = p[:, :, 0] - lam_full * p[:, :, 1]
        return jnp.einsum('bhqk,bkhv->bqhv', attn, v)

    starts = jnp.arange(nb, dtype=jnp.int32) * Q_BLOCK
    out = lax.map(block, (qb, starts))
    out = out.transpose(1, 0, 2, 3, 4).reshape(B, L, DA_HEADS, DA_V_DIM)
    out = rmsnorm(out, norm_g.reshape(DA_HEADS, DA_V_DIM)) * (1.0 - lambda_init)
    return out.reshape(B, L, DA_WIDTH).astype(dtype)


def s5_branch(u, lam_re, lam_im, log_dt, b_re, b_im, c_re, c_im, d_skip, w_glu):
    dtype = u.dtype
    B, L, _ = u.shape
    uf = u.astype(jnp.float32)
    ug = uf.reshape(B, L, S5_GROUPS, S5_GROUP)
    lam_re = lam_re.astype(jnp.float32)
    lam_im = lam_im.astype(jnp.float32)
    dt = jnp.exp(log_dt.astype(jnp.float32))[:, None]
    mag = jnp.exp(lam_re * dt)
    a_re = mag * jnp.cos(lam_im * dt)
    a_im = mag * jnp.sin(lam_im * dt)
    den = lam_re * lam_re + lam_im * lam_im
    z_re = ((a_re - 1.0) * lam_re + a_im * lam_im) / den
    z_im = (a_im * lam_re - (a_re - 1.0) * lam_im) / den
    b_re = b_re.astype(jnp.float32)
    b_im = b_im.astype(jnp.float32)
    bb_re = z_re[..., None] * b_re - z_im[..., None] * b_im
    bb_im = z_re[..., None] * b_im + z_im[..., None] * b_re
    bu_re = jnp.einsum('gpc,blgc->blgp', bb_re, ug)
    bu_im = jnp.einsum('gpc,blgc->blgp', bb_im, ug)
    a_re_t = jnp.broadcast_to(a_re, (1, L, S5_GROUPS, S5_STATE))
    a_im_t = jnp.broadcast_to(a_im, (1, L, S5_GROUPS, S5_STATE))

    def combine(e1, e2):
        a1r, a1i, b1r, b1i = e1
        a2r, a2i, b2r, b2i = e2
        return (a2r * a1r - a2i * a1i,
                a2r * a1i + a2i * a1r,
                a2r * b1r - a2i * b1i + b2r,
                a2r * b1i + a2i * b1r + b2i)

    _, _, x_re, x_im = lax.associative_scan(combine, (a_re_t, a_im_t, bu_re, bu_im), axis=1)
    y = (jnp.einsum('gcp,blgp->blgc', c_re.astype(jnp.float32), x_re)
         - jnp.einsum('gcp,blgp->blgc', c_im.astype(jnp.float32), x_im))
    y = y.reshape(B, L, S5_WIDTH) + d_skip.astype(jnp.float32) * uf
    y = jax.nn.gelu(y)
    ab = jnp.einsum('blw,wv->blv', y, w_glu.astype(jnp.float32))
    a, g = jnp.split(ab, 2, axis=-1)
    return (a * jax.nn.sigmoid(g)).astype(dtype)


def setup_inputs(seed: int = 0) -> dict:
    key = jax.random.key(seed)
    ks = jax.random.split(key, 32)
    f32 = jnp.float32

    def nrm(k, shape, scale):
        return jax.random.normal(k, shape, f32) * scale

    def gain(k, shape):
        return 1.0 + 0.05 * jax.random.normal(k, shape, f32)

    x = nrm(ks[0], (BATCH, SEQ, D_MODEL), 1.0)
    norm_mix_pre = gain(ks[1], (DEPTH, D_MODEL))
    norm_mix_post = gain(ks[2], (DEPTH, D_MODEL))
    norm_ffn_pre = gain(ks[3], (DEPTH, D_MODEL))
    norm_ffn_post = gain(ks[4], (DEPTH, D_MODEL))
    w_in = nrm(ks[5], (DEPTH, D_MODEL, N_IN), D_MODEL ** -0.5)
    b_i = nrm(ks[6], (DEPTH, M_HEADS), 0.1)
    b_f = jnp.linspace(3.0, 6.0, M_HEADS, dtype=f32) + nrm(ks[7], (DEPTH, M_HEADS), 0.1)
    mlstm_b_if = jnp.stack([b_i, b_f], axis=1)
    mlstm_conv = nrm(ks[8], (DEPTH, M_CONV, 2 * M_WIDTH), M_CONV ** -0.5)
    mlstm_norm = gain(ks[9], (DEPTH, M_WIDTH))
    diff_lambda = nrm(ks[10], (DEPTH, 4, DA_HEAD_DIM), 0.1)
    diff_norm = gain(ks[11], (DEPTH, DA_WIDTH))
    rel_bias = nrm(ks[12], (REL_BUCKETS, DA_HEADS), 0.5)
    n_idx = jnp.arange(S5_STATE, dtype=f32)
    s5_lambda_re = -0.5 + nrm(ks[13], (DEPTH, S5_GROUPS, S5_STATE), 1e-3)
    s5_lambda_im = math.pi * n_idx + nrm(ks[14], (DEPTH, S5_GROUPS, S5_STATE), 1e-3)
    s5_log_dt = jax.random.uniform(ks[15], (DEPTH, S5_GROUPS), f32, math.log(1e-3), math.log(1e-1))
    s5_b_re = nrm(ks[16], (DEPTH, S5_GROUPS, S5_STATE, S5_GROUP), (2 * S5_GROUP) ** -0.5)
    s5_b_im = nrm(ks[17], (DEPTH, S5_GROUPS, S5_STATE, S5_GROUP), (2 * S5_GROUP) ** -0.5)
    s5_c_re = nrm(ks[18], (DEPTH, S5_GROUPS, S5_GROUP, S5_STATE), (2 * S5_STATE) ** -0.5)
    s5_c_im = nrm(ks[19], (DEPTH, S5_GROUPS, S5_GROUP, S5_STATE), (2 * S5_STATE) ** -0.5)
    s5_d = nrm(ks[20], (DEPTH, S5_WIDTH), 0.5)
    s5_w_glu = nrm(ks[21], (DEPTH, S5_WIDTH, 2 * S5_WIDTH), S5_WIDTH ** -0.5)
    w_branch = nrm(ks[22], (DEPTH, N_BRANCH, BRANCH_WIDTH, D_MODEL), BRANCH_WIDTH ** -0.5)
    w_out = nrm(ks[23], (DEPTH, D_MODEL, D_MODEL), D_MODEL ** -0.5)
    w_up = nrm(ks[24], (DEPTH, D_MODEL, 2 * D_FF), D_MODEL ** -0.5)
    ffn_conv = nrm(ks[25], (DEPTH, FFN_CONV, 2 * D_FF), FFN_CONV ** -0.5)
    ffn_conv_b = nrm(ks[26], (DEPTH, 2 * D_FF), 0.02)
    w_down = nrm(ks[27], (DEPTH, D_FF, D_MODEL), D_FF ** -0.5)
    return {'x': x, 'norm_mix_pre': norm_mix_pre, 'norm_mix_post': norm_mix_post,
            'norm_ffn_pre': norm_ffn_pre, 'norm_ffn_post': norm_ffn_post, 'w_in': w_in,
            'mlstm_b_if': mlstm_b_if, 'mlstm_conv': mlstm_conv, 'mlstm_norm': mlstm_norm,
            'diff_lambda': diff_lambda, 'diff_norm': diff_norm, 'rel_bias': rel_bias,
            's5_lambda_re': s5_lambda_re, 's5_lambda_im': s5_lambda_im, 's5_log_dt': s5_log_dt,
            's5_b_re': s5_b_re, 's5_b_im': s5_b_im, 's5_c_re': s5_c_re, 's5_c_im': s5_c_im,
            's5_d': s5_d, 's5_w_glu': s5_w_glu, 'w_branch': w_branch, 'w_out': w_out,
            'w_up': w_up, 'ffn_conv': ffn_conv, 'ffn_conv_b': ffn_conv_b, 'w_down': w_down}


def reference(x, norm_mix_pre, norm_mix_post, norm_ffn_pre, norm_ffn_post, w_in,
              mlstm_b_if, mlstm_conv, mlstm_norm, diff_lambda, diff_norm, rel_bias,
              s5_lambda_re, s5_lambda_im, s5_log_dt, s5_b_re, s5_b_im, s5_c_re, s5_c_im,
              s5_d, s5_w_glu, w_branch, w_out, w_up, ffn_conv, ffn_conv_b, w_down):
    B, L, _ = x.shape
    split_points = [int(s) for s in np.cumsum(IN_SIZES)[:-1]]
    for layer in range(DEPTH):
        h = rmsnorm(x, norm_mix_pre[layer])
        proj = jnp.einsum('bld,dn->bln', h, w_in[layer])
        (q_m, k_m, v_m, o_m, i_m, f_m, q_d, k_d, v_d, u_s,
         gate_pre) = jnp.split(proj, split_points, axis=-1)
        y_a = mlstm_branch(q_m, k_m, v_m, o_m, i_m + mlstm_b_if[layer, 0],
                           f_m + mlstm_b_if[layer, 1], mlstm_conv[layer], mlstm_norm[layer])
        lambda_init = 0.8 - 0.6 * math.exp(-0.3 * layer)
        y_b = diff_attention_branch(q_d, k_d, v_d, diff_lambda[layer], diff_norm[layer],
                                    rel_bias, lambda_init)
        y_c = s5_branch(u_s, s5_lambda_re[layer], s5_lambda_im[layer], s5_log_dt[layer],
                        s5_b_re[layer], s5_b_im[layer], s5_c_re[layer], s5_c_im[layer],
                        s5_d[layer], s5_w_glu[layer])
        ys = jnp.stack([y_a, y_b, y_c], axis=2)
        z = jnp.einsum('blnw,nwd->blnd', ys, w_branch[layer])
        gates = jax.nn.sigmoid(gate_pre.reshape(B, L, N_BRANCH, D_MODEL))
        merged = jnp.sum(gates * z, axis=2)
        mix = jnp.einsum('bld,de->ble', merged, w_out[layer])
        x = x + rmsnorm(mix, norm_mix_post[layer])
        h = rmsnorm(x, norm_ffn_pre[layer])
        up = causal_dwconv(jnp.einsum('bld,df->blf', h, w_up[layer]), ffn_conv[layer]) + ffn_conv_b[layer]
        a, v = jnp.split(up, 2, axis=-1)
        ffn = jnp.einsum('blf,fd->bld', jax.nn.gelu(a) * v, w_down[layer])
        x = x + rmsnorm(ffn, norm_ffn_post[layer])
    return x
```

```cpp
#include <hip/hip_runtime.h>
#include <cstdio>
#include <cstdint>
namespace pg8 {
#define PG8_LAS __attribute__((address_space(3)))
typedef unsigned short bf16_t;
typedef short bf16x8 __attribute__((ext_vector_type(8)));
typedef float f32x4 __attribute__((ext_vector_type(4)));
typedef unsigned u32x4 __attribute__((ext_vector_type(4)));
constexpr int BM = 256, BK = 64, HALF = 128, HTB = HALF * BK * 2  , STAGE_BYTES = 8 * HTB, NXCD = 8, WGM = 8;

__host__ __device__ __forceinline__ int lds_byte(int r, int c) { const int st = (r >> 4) * 2 + (c >> 5), rr = r & 15, cc = c & 31, ob = rr * 64 + cc * 2; return st * 1024 + (ob ^ (((ob >> 9) & 1) << 5)); }
__host__ __device__ __forceinline__ void stage_rc(int b, int& R, int& C) { const int st = b / 1024, sb = b % 1024, swz = sb ^ (((sb >> 9) & 1) << 5); R = (st >> 1) * 16 + swz / 64; C = (st & 1) * 32 + (swz % 64) / 2; }
__host__ __device__ __forceinline__ int perm32(int rho) { const int n = rho >> 4, i = rho & 15; return 8 * (i >> 2) + 4 * n + (i & 3); }

struct Unit { int pm, pn; int kb, nk, part; };
struct Gemm { const bf16_t* A; const bf16_t* Bt; int M, N, K; float* pbuf; };

struct StaticOrder {
    static constexpr bool HAS_PARK = false, HAS_MID = false;
    int nM, nN, nwg, G, c;
    __host__ __device__ void init(int M, int N, int G_, int c_) { nM = M / BM; nN = N / BM; nwg = nM * nN; G = G_; c = c_; }
    __host__ __device__ bool next(int i, Unit& u) const {
        const long L = (long)i * G + c; if (L >= nwg) return false;
        int wgid = (int)L; { const int q = nwg / NXCD, r = nwg % NXCD, xcd = wgid % NXCD, off = wgid / NXCD; wgid = (xcd < r ? xcd * (q + 1) : r * (q + 1) + (xcd - r) * q) + off; }
        const int nig = WGM * nN, gid = wgid / nig, fm = gid * WGM, gsz = (nM - fm) < WGM ? (nM - fm) : WGM;
        u.pm = fm + ((wgid % nig) % gsz); u.pn = (wgid % nig) / gsz; u.kb = 0; u.nk = 0; u.part = 0; return true;
    }
    __device__ __forceinline__ void a_ready(const Unit&) const {}
    __device__ __forceinline__ void done(const Unit&) const {}
};
struct StaggerOrder {
    static constexpr bool HAS_PARK = true, HAS_MID = false;
    StaticOrder so; int n, a, nt;
    __host__ __device__ void init(int M, int N, int G_, int c_, int nt_) { so.init(M, N, G_, c_); nt = nt_; n = c_ < so.nwg ? (so.nwg - c_ + G_ - 1) / G_ : 0;
        a = ((c_ & 7) * (nt_ / 8)) & ~3;
        if (a < 4 || nt_ - a < 4 || n < 2) a = 0; }
    __host__ __device__ bool next(int i, Unit& u) const {
        if (a == 0) return so.next(i, u);
        if (i == 0) { so.next(0, u); u.kb = 0; u.nk = a; u.part = 1; return true; }
        if (i < n) return so.next(i, u);
        if (i == n) { so.next(0, u); u.kb = a; u.nk = nt - a; u.part = 2; return true; }
        return false;
    }
    __device__ __forceinline__ void a_ready(const Unit&) const {}
    __device__ __forceinline__ void done(const Unit&) const {}
};


typedef int i32x4 __attribute__((ext_vector_type(4)));
template <bool I8> __device__ __forceinline__ f32x4 mma_op(bf16x8 b, bf16x8 a, f32x4 c) {
    if constexpr (I8) return __builtin_bit_cast(f32x4, __builtin_amdgcn_mfma_i32_16x16x64_i8(__builtin_bit_cast(i32x4, b), __builtin_bit_cast(i32x4, a), __builtin_bit_cast(i32x4, c), 0, 0, 0));
    else return __builtin_amdgcn_mfma_f32_16x16x32_bf16(b, a, c, 0, 0, 0);
}

#ifndef USE_STAGGER
struct GemmOrder : StaticOrder { __host__ __device__ void init(int M, int N, int G_, int c_, int) { StaticOrder::init(M, N, G_, c_); } };
#else
typedef StaggerOrder GemmOrder;
#endif

typedef float f32x2_t __attribute__((ext_vector_type(2))); typedef __bf16 bf16x2_t __attribute__((ext_vector_type(2)));
__device__ __forceinline__ unsigned cvt_pk_bf16(float lo, float hi) { const f32x2_t v = {lo, hi}; const bf16x2_t b = __builtin_convertvector(v, bf16x2_t); return __builtin_bit_cast(unsigned, b); }
__device__ __forceinline__ float sigm(float x) { return __builtin_amdgcn_rcpf(1.0f + __builtin_amdgcn_exp2f(-1.4426950409f * x)); }

struct EpiBf16 {
    static constexpr bool PERM = true, AFTER_DRAIN = false;
    bf16_t* O; int ldc; int skip; int sig_tile;
    int hole_tile, hole_cols;
    __device__ __forceinline__ void mid(f32x4 (&acc)[2][2][4][2], const Unit& u, int wr, int wc, int fr, int fq) const {}
    __device__ __forceinline__ void operator()(const f32x4 (&acc)[2][2][4][2], const Unit& u, int wr, int wc, int fr, int fq) const {
        const int row0 = u.pm * BM + wr * 64 + fr; const int col0 = u.pn * BM + wc * 32 + 8 * fq + (u.pn >= hole_tile ? hole_cols : 0);
#ifdef DBG_NULL_EPI
        if (skip) { asm volatile("" :: "v"(acc[0][0][0][0]), "v"(acc[1][1][3][1])); return; }
#endif
        const bool sg = u.pn >= sig_tile;
#pragma unroll
        for (int ai = 0; ai < 2; ++ai)
#pragma unroll
            for (int m = 0; m < 4; ++m) { bf16_t* rowp = O + (size_t)(row0 + ai * HALF + m * 16) * ldc + col0;
#pragma unroll
                for (int bj = 0; bj < 2; ++bj) { f32x4 v0 = acc[ai][bj][m][0], v1 = acc[ai][bj][m][1];
                    if (sg) {
#pragma unroll
                        for (int j = 0; j < 4; ++j) { v0[j] = sigm(v0[j]); v1[j] = sigm(v1[j]); } }
                    u32x4 w; w.x = cvt_pk_bf16(v0[0], v0[1]); w.y = cvt_pk_bf16(v0[2], v0[3]); w.z = cvt_pk_bf16(v1[0], v1[1]); w.w = cvt_pk_bf16(v1[2], v1[3]);
#if defined(EPI_SC1)
                    asm volatile("global_store_dwordx4 %0, %1, off sc1" :: "v"(rowp + bj * HALF), "v"(w) : "memory");
#elif defined(EPI_NT)
                    __builtin_nontemporal_store(w, (u32x4*)(rowp + bj * HALF));
#else
                    *(u32x4*)(rowp + bj * HALF) = w;
#endif
                    } }
    }
};
struct EpiNull {
    static constexpr bool PERM = true, AFTER_DRAIN = false;
    float* sink;
    __device__ __forceinline__ void mid(f32x4 (&acc)[2][2][4][2], const Unit& u, int wr, int wc, int fr, int fq) const {}
    __device__ __forceinline__ void operator()(const f32x4 (&acc)[2][2][4][2], const Unit& u, int wr, int wc, int fr, int fq) const {
#pragma unroll
        for (int ai = 0; ai < 2; ++ai)
#pragma unroll
            for (int m = 0; m < 4; ++m)
#pragma unroll
                for (int bj = 0; bj < 2; ++bj) { asm volatile("" :: "v"(acc[ai][bj][m][0]), "v"(acc[ai][bj][m][1])); }
    }
};
struct EpiGateI8 {
    static constexpr bool PERM = true, AFTER_DRAIN = false;
    bf16_t* O; int ldc; int col_off; const float* sa; const float* sb;
    __device__ __forceinline__ void dequant(f32x4 (&acc)[2][2][4][2], const Unit& u, int wr, int wc, int fr, int fq) const {}
    __device__ __forceinline__ void mid(f32x4 (&acc)[2][2][4][2], const Unit& u, int wr, int wc, int fr, int fq) const {}
    __device__ __forceinline__ void operator()(const f32x4 (&acc)[2][2][4][2], const Unit& u, int wr, int wc, int fr, int fq) const {
        asm volatile("" : "+v"(fr), "+v"(fq));
        const int row0 = u.pm * BM + wr * 64 + fr; const int col0 = u.pn * BM + wc * 32 + 8 * fq;
        f32x4 sbv[2][2];
#pragma unroll
        for (int bj = 0; bj < 2; ++bj)
#pragma unroll
            for (int n = 0; n < 2; ++n) sbv[bj][n] = *(const f32x4*)(sb + col0 + bj * HALF + 4 * n);
#pragma unroll
        for (int ai = 0; ai < 2; ++ai)
#pragma unroll
            for (int m = 0; m < 4; ++m) { const int row = row0 + ai * HALF + m * 16; const float s = sa[row]; bf16_t* rowp = O + (size_t)row * ldc + col0 + (u.pn < 8 ? 2048 : 4096);
                if (u.pn >= 16 && u.pn < 32) {
                    bf16_t* gp = O + (size_t)row * ldc + 8192 + (u.pn - 16) * HALF + wc * 32 + 8 * fq;
                    const i32x4 a0 = __builtin_bit_cast(i32x4, acc[ai][0][m][0]), a1 = __builtin_bit_cast(i32x4, acc[ai][0][m][1]), b0 = __builtin_bit_cast(i32x4, acc[ai][1][m][0]), b1 = __builtin_bit_cast(i32x4, acc[ai][1][m][1]);
                    const f32x4 ta0 = sbv[0][0] * s, ta1 = sbv[0][1] * s, tb0 = sbv[1][0] * s, tb1 = sbv[1][1] * s; float r[8], g1[8];
#pragma unroll
                    for (int j = 0; j < 4; ++j) {
                        const float h0 = 1.0f + __builtin_amdgcn_exp2f(-1.4426950409f * ((float)b0[j] * tb0[j])), h1 = 1.0f + __builtin_amdgcn_exp2f(-1.4426950409f * ((float)b1[j] * tb1[j]));
                        g1[j] = __builtin_amdgcn_rcpf(h0); g1[4 + j] = __builtin_amdgcn_rcpf(h1);
                        r[j] = sigm((float)a0[j] * ta0[j]) * h0; r[4 + j] = sigm((float)a1[j] * ta1[j]) * h1; }
                    u32x4 w; w.x = cvt_pk_bf16(r[0], r[1]); w.y = cvt_pk_bf16(r[2], r[3]); w.z = cvt_pk_bf16(r[4], r[5]); w.w = cvt_pk_bf16(r[6], r[7]);
                    *(u32x4*)gp = w;
                    w.x = cvt_pk_bf16(g1[0], g1[1]); w.y = cvt_pk_bf16(g1[2], g1[3]); w.z = cvt_pk_bf16(g1[4], g1[5]); w.w = cvt_pk_bf16(g1[6], g1[7]);
                    *(u32x4*)(gp + 2048) = w;
                    continue; }
#pragma unroll
                for (int bj = 0; bj < 2; ++bj) { const i32x4 i0 = __builtin_bit_cast(i32x4, acc[ai][bj][m][0]), i1 = __builtin_bit_cast(i32x4, acc[ai][bj][m][1]);
                    const f32x4 t0 = sbv[bj][0] * s, t1 = sbv[bj][1] * s; float v[8];
#pragma unroll
                    for (int j = 0; j < 4; ++j) { v[j] = (float)i0[j] * t0[j]; v[4 + j] = (float)i1[j] * t1[j]; }
                    if (u.pn >= 16) {
#pragma unroll
                        for (int j = 0; j < 8; ++j) v[j] = sigm(v[j]); }
                    u32x4 w; w.x = cvt_pk_bf16(v[0], v[1]); w.y = cvt_pk_bf16(v[2], v[3]); w.z = cvt_pk_bf16(v[4], v[5]); w.w = cvt_pk_bf16(v[6], v[7]);
                    *(u32x4*)(rowp + bj * HALF) = w; } }
    }
};
struct EpiGlu {
    static constexpr bool PERM = true, AFTER_DRAIN = false;
    bf16_t* O; int ldc;
    __device__ __forceinline__ void mid(f32x4 (&acc)[2][2][4][2], const Unit& u, int wr, int wc, int fr, int fq) const {}
    __device__ __forceinline__ void operator()(const f32x4 (&acc)[2][2][4][2], const Unit& u, int wr, int wc, int fr, int fq) const {
        const int row0 = u.pm * BM + wr * 64 + fr; const int col0 = u.pn * HALF + wc * 32 + 8 * fq;
#pragma unroll
        for (int ai = 0; ai < 2; ++ai)
#pragma unroll
            for (int m = 0; m < 4; ++m) { bf16_t* rowp = O + (size_t)(row0 + ai * HALF + m * 16) * ldc + col0;
                const f32x4 a0 = acc[ai][0][m][0], a1 = acc[ai][0][m][1], g0 = acc[ai][1][m][0], g1 = acc[ai][1][m][1];
                float o[8];
#pragma unroll
                for (int j = 0; j < 4; ++j) { o[j] = a0[j] * sigm(g0[j]); o[4 + j] = a1[j] * sigm(g1[j]); }
                u32x4 w; w.x = cvt_pk_bf16(o[0], o[1]); w.y = cvt_pk_bf16(o[2], o[3]); w.z = cvt_pk_bf16(o[4], o[5]); w.w = cvt_pk_bf16(o[6], o[7]);
                *(u32x4*)rowp = w; }
    }
};
template <int CTRL> __device__ __forceinline__ float dpp_mov_old(float oldv, float x) {
    return __builtin_bit_cast(float, __builtin_amdgcn_update_dpp(__builtin_bit_cast(int, oldv), __builtin_bit_cast(int, x), CTRL, 0xf, 0xf, false)); }
template <int CTRL> __device__ __forceinline__ float dpp_mov_any(float x) {
    return __builtin_bit_cast(float, __builtin_amdgcn_mov_dpp(__builtin_bit_cast(int, x), CTRL, 0xf, 0xf, false)); }
__device__ __forceinline__ float gelu_mul(float a, float v) {
    const float t = a * ((a * a) * -0.1029432396f + -2.3022081986f);
    return (a * v) * __builtin_amdgcn_rcpf(1.0f + __builtin_amdgcn_exp2f(t)); }
__device__ __forceinline__ float gelu_t(float a) { const float u = a * (1.0f + 0.044715f * a * a); return a * sigm(1.5957691216f * u); }
typedef unsigned u32x2 __attribute__((ext_vector_type(2)));
template <bool Q8> struct EpiUpConv {
    static constexpr bool PERM = true, AFTER_DRAIN = false;
    bf16_t* act; bf16_t* raw; const float* cw; const float* cb; int dff, nup;
    const float* sa; const float* sb;
    __device__ __forceinline__ void dequant(f32x4 (&acc)[2][2][4][2], const Unit& u, int wr, int wc, int fr, int fq) const {
    }
    __device__ __forceinline__ void mid(f32x4 (&acc)[2][2][4][2], const Unit& u, int wr, int wc, int fr, int fq) const {}
    __device__ __forceinline__ void operator()(const f32x4 (&acc)[2][2][4][2], const Unit& u, int wr, int wc, int fr, int fq) const {
        asm volatile("" : "+v"(fr), "+v"(fq));
        const int cl0 = u.pn * HALF + wc * 32 + 8 * fq;
#pragma unroll
        for (int ai = 0; ai < 2; ++ai) {
            const int rowb = u.pm * BM + ai * HALF + wr * 64;
            float sr[4];
#pragma unroll
            for (int m = 0; m < 4; ++m) sr[m] = Q8 ? sa[rowb + 16 * m + fr] : 1.0f;
#pragma unroll
            for (int n = 0; n < 2; ++n) {
                const int cl = cl0 + 4 * n;
                f32x4 wa[3], wv[3];
#pragma unroll
                for (int jj = 0; jj < 3; ++jj) { wa[jj] = *(const f32x4*)(cw + (size_t)jj * nup + cl); wv[jj] = *(const f32x4*)(cw + (size_t)jj * nup + dff + cl); }
                const f32x4 ba = *(const f32x4*)(cb + cl), bv = *(const f32x4*)(cb + dff + cl);
                if (Q8) { const f32x4 sba = *(const f32x4*)(sb + u.pn * BM + wc * 32 + 8 * fq + 4 * n), sbv = *(const f32x4*)(sb + u.pn * BM + HALF + wc * 32 + 8 * fq + 4 * n);
#pragma unroll
                    for (int jj = 0; jj < 3; ++jj) { wa[jj] = wa[jj] * sba; wv[jj] = wv[jj] * sbv; } }
                float o[4][4];
#pragma unroll
                for (int j = 0; j < 4; ++j) {
                    float pa = 0.f, pv = 0.f;
#pragma unroll
                    for (int m = 0; m < 4; ++m) {
                        const i32x4 ia_ = __builtin_bit_cast(i32x4, acc[ai][0][m][n]), iv_ = __builtin_bit_cast(i32x4, acc[ai][1][m][n]);
                        const float xa = Q8 ? (float)ia_[j] * sr[m] : acc[ai][0][m][n][j];
                        const float xv = Q8 ? (float)iv_[j] * sr[m] : acc[ai][1][m][n][j];
                        const float a1 = dpp_mov_old<0x111>(dpp_mov_any<0x121>(pa), xa), a2 = dpp_mov_old<0x112>(dpp_mov_any<0x122>(pa), xa);
                        const float v1 = dpp_mov_old<0x111>(dpp_mov_any<0x121>(pv), xv), v2 = dpp_mov_old<0x112>(dpp_mov_any<0x122>(pv), xv);
                        const float ya = wa[0][j] * a2 + (wa[1][j] * a1 + (wa[2][j] * xa + ba[j]));
                        const float yv = wv[0][j] * v2 + (wv[1][j] * v1 + (wv[2][j] * xv + bv[j]));
                        o[m][j] = gelu_mul(ya, yv);
                        pa = xa; pv = xv; } }
#pragma unroll
                for (int m = 0; m < 4; ++m) { u32x2 w2; w2.x = cvt_pk_bf16(o[m][0], o[m][1]); w2.y = cvt_pk_bf16(o[m][2], o[m][3]);
                    *(u32x2*)(act + (size_t)(rowb + 16 * m + fr) * dff + cl) = w2; }
                asm volatile("" ::: "memory");
            }
            const int ridx = fr < 2 ? fr : fr - 12;
            if (fr < 2 || fr >= 14) { const int m = fr < 2 ? 0 : 3;
                f32x4 a0 = fr < 2 ? acc[ai][0][0][0] : acc[ai][0][3][0], a1 = fr < 2 ? acc[ai][0][0][1] : acc[ai][0][3][1];
                f32x4 v0 = fr < 2 ? acc[ai][1][0][0] : acc[ai][1][3][0], v1 = fr < 2 ? acc[ai][1][0][1] : acc[ai][1][3][1];
                if (Q8) { const float s = fr < 2 ? sr[0] : sr[3]; const float* sbp = sb + u.pn * BM + wc * 32 + 8 * fq;
                    const f32x4 sa0 = *(const f32x4*)sbp, sa1 = *(const f32x4*)(sbp + 4), sv0 = *(const f32x4*)(sbp + HALF), sv1 = *(const f32x4*)(sbp + HALF + 4);
                    const i32x4 ia0 = __builtin_bit_cast(i32x4, a0), ia1 = __builtin_bit_cast(i32x4, a1), iv0 = __builtin_bit_cast(i32x4, v0), iv1 = __builtin_bit_cast(i32x4, v1);
                    a0 = (f32x4){(float)ia0[0], (float)ia0[1], (float)ia0[2], (float)ia0[3]} * (sa0 * s); a1 = (f32x4){(float)ia1[0], (float)ia1[1], (float)ia1[2], (float)ia1[3]} * (sa1 * s);
                    v0 = (f32x4){(float)iv0[0], (float)iv0[1], (float)iv0[2], (float)iv0[3]} * (sv0 * s); v1 = (f32x4){(float)iv1[0], (float)iv1[1], (float)iv1[2], (float)iv1[3]} * (sv1 * s); }
                bf16_t* rp = raw + ((size_t)(rowb >> 6) * 4 + ridx) * 2 * dff + cl0; (void)m;
                *(u32x4*)rp = (u32x4){cvt_pk_bf16(a0[0], a0[1]), cvt_pk_bf16(a0[2], a0[3]), cvt_pk_bf16(a1[0], a1[1]), cvt_pk_bf16(a1[2], a1[3])};
                *(u32x4*)(rp + dff) = (u32x4){cvt_pk_bf16(v0[0], v0[1]), cvt_pk_bf16(v0[2], v0[3]), cvt_pk_bf16(v1[0], v1[1]), cvt_pk_bf16(v1[2], v1[3])}; }
        }
    }
};
struct EpiBranch {
    static constexpr bool PERM = true, AFTER_DRAIN = false;
    const bf16_t* proj; int ldp; int gate_col; bf16_t* merged; const bf16_t* ones;
    __device__ __forceinline__ void mid(f32x4 (&acc)[2][2][4][2], const Unit& u, int wr, int wc, int fr, int fq) const {
        const int n = u.pn >> 3, pn = u.pn & 7, pm = u.pm & 31;
        const int row0 = pm * BM + wr * 64 + fr; const int col0 = pn * BM + wc * 32 + 8 * fq;
#pragma unroll
        for (int ai = 0; ai < 2; ++ai)
#pragma unroll
            for (int mp = 0; mp < 1; ++mp) {
                u32x4 ga[4][2], gb[4][2];
#pragma unroll
                for (int mm = 0; mm < 4; ++mm)
#pragma unroll
                    for (int bj = 0; bj < 2; ++bj) { const bf16_t* gp = proj + (size_t)(row0 + ai * HALF + mm * 16) * ldp + gate_col + n * 2048 + col0 + bj * HALF;
                        ga[mm][bj] = *(const u32x4*)gp; gb[mm][bj] = *(const u32x4*)(n == 0 ? ones : gp + 2048); }
#pragma unroll
                for (int mm = 0; mm < 4; ++mm)
#pragma unroll
                    for (int bj = 0; bj < 2; ++bj) { const int m = mm; const u32x4 a = ga[mm][bj], b = gb[mm][bj];
                        f32x4 v0 = acc[ai][bj][m][0], v1 = acc[ai][bj][m][1];
                        v0[0] *= __uint_as_float(a.x << 16) * __builtin_amdgcn_rcpf(__uint_as_float(b.x << 16)); v0[1] *= __uint_as_float(a.x & 0xffff0000u) * __builtin_amdgcn_rcpf(__uint_as_float(b.x & 0xffff0000u));
                        v0[2] *= __uint_as_float(a.y << 16) * __builtin_amdgcn_rcpf(__uint_as_float(b.y << 16)); v0[3] *= __uint_as_float(a.y & 0xffff0000u) * __builtin_amdgcn_rcpf(__uint_as_float(b.y & 0xffff0000u));
                        v1[0] *= __uint_as_float(a.z << 16) * __builtin_amdgcn_rcpf(__uint_as_float(b.z << 16)); v1[1] *= __uint_as_float(a.z & 0xffff0000u) * __builtin_amdgcn_rcpf(__uint_as_float(b.z & 0xffff0000u));
                        v1[2] *= __uint_as_float(a.w << 16) * __builtin_amdgcn_rcpf(__uint_as_float(b.w << 16)); v1[3] *= __uint_as_float(a.w & 0xffff0000u) * __builtin_amdgcn_rcpf(__uint_as_float(b.w & 0xffff0000u));
                        acc[ai][bj][m][0] = v0; acc[ai][bj][m][1] = v1; }
                asm volatile("" ::: "memory"); }
    }
    __device__ __forceinline__ void operator()(const f32x4 (&acc)[2][2][4][2], const Unit& u, int wr, int wc, int fr, int fq) const {
        const int n = u.pn >> 3, pn = u.pn & 7, pm = u.pm & 31;
        const int row0 = pm * BM + wr * 64 + fr; const int col0 = pn * BM + wc * 32 + 8 * fq;
#pragma unroll
        for (int ai = 0; ai < 2; ++ai)
#pragma unroll
            for (int m = 0; m < 4; ++m) { const size_t row = (size_t)(row0 + ai * HALF + m * 16);
#pragma unroll
                for (int bj = 0; bj < 2; ++bj) { const int col = col0 + bj * HALF;
                    const u32x4 gw = *(const u32x4*)(proj + row * ldp + gate_col + n * 2048 + col);
                    f32x4 v0 = acc[ai][bj][m][0], v1 = acc[ai][bj][m][1];
                    v0[0] *= __uint_as_float(gw.x << 16); v0[1] *= __uint_as_float(gw.x & 0xffff0000u); v0[2] *= __uint_as_float(gw.y << 16); v0[3] *= __uint_as_float(gw.y & 0xffff0000u);
                    v1[0] *= __uint_as_float(gw.z << 16); v1[1] *= __uint_as_float(gw.z & 0xffff0000u); v1[2] *= __uint_as_float(gw.w << 16); v1[3] *= __uint_as_float(gw.w & 0xffff0000u);
                    u32x4 w; w.x = cvt_pk_bf16(v0[0], v0[1]); w.y = cvt_pk_bf16(v0[2], v0[3]); w.z = cvt_pk_bf16(v1[0], v1[1]); w.w = cvt_pk_bf16(v1[2], v1[3]);
                    *(u32x4*)(merged + row * 2048 + col) = w; }
                if (m == 3) asm volatile("" ::: "memory"); }
    }
};
struct BranchOrder {
    static constexpr bool HAS_PARK = false, HAS_MID = true;
    StaticOrder so; int G, c;
    __host__ __device__ void init(int G_, int c_) { so.init(32 * BM, 8 * BM, 1, 0); G = G_; c = c_; }
    __host__ __device__ bool next(int i, Unit& u) const {
        const int tile = (i / 3) * G + c, n = i % 3; if (tile >= 256) return false;
        Unit t; so.next(tile, t); u = t; u.pm = t.pm + 32 * n; u.pn = t.pn + 8 * n; u.part = n < 2 ? 3 : 0; return true;
    }
    __device__ __forceinline__ void a_ready(const Unit&) const {}
    __device__ __forceinline__ void done(const Unit&) const {}
};
template <class Epi, class Sched, bool ALIGN_EPI = false, bool SP2 = false, bool I8 = false>
__device__ __forceinline__ void gemm_phase(PG8_LAS unsigned char* lds, const Gemm g, const Sched& S, const Epi& E) {
    int tid_ = threadIdx.x; asm volatile("" : "+v"(tid_)); const int tid = tid_, wid = __builtin_amdgcn_readfirstlane(tid >> 6), lane = tid & 63, wr = wid >> 2, wc = wid & 3, fr = lane & 15, fq = lane >> 4;
    const int K = I8 ? g.K / 2 : g.K, nt = K / BK;
    unsigned voffA[2], voffB[2];
#pragma unroll
    for (int i = 0; i < 2; ++i) { int R, C; stage_rc(tid * 16 + i * 8192, R, C); const int Rb = Epi::PERM ? ((R & ~31) + perm32(R & 31)) : R;
        voffA[i] = (unsigned)(R * K + C) * 2u; voffB[i] = (unsigned)(Rb * K + C) * 2u; }
    const size_t kstep = (size_t)(BK * 2);
    const size_t hstep = (size_t)HALF * K * 2;
    const size_t tstep = 2 * hstep;
    const unsigned ldsw = (unsigned)wid * 1024u;
    const int aoff = lds_byte(wr * 64 + fr, fq * 8), boff = lds_byte(wc * 32 + fr, fq * 8);
#define PG8_SA(b, h) (((b) * 2 + (h)) * HTB)
#define PG8_SB(b, h) ((4 + (b) * 2 + (h)) * HTB)
#define PG8_STAGE(bufoff, gbase, voff) do { _Pragma("unroll") for (int _i = 0; _i < 2; ++_i) \
        __builtin_amdgcn_global_load_lds((const unsigned*)((const char*)(gbase) + (voff)[_i]), (PG8_LAS unsigned*)(lds + (bufoff) + ldsw + _i * 8192), 16, 0, 0); } while (0)
#define PG8_LDA(dst, b, h) do { _Pragma("unroll") for (int m = 0; m < 4; ++m) _Pragma("unroll") for (int k = 0; k < 2; ++k) dst[m][k] = *(const PG8_LAS bf16x8*)(lds + PG8_SA(b, h) + aoff + m * 2048 + k * 1024); } while (0)
#define PG8_LDB(dst, b, h) do { _Pragma("unroll") for (int n = 0; n < 2; ++n) _Pragma("unroll") for (int k = 0; k < 2; ++k) dst[n][k] = *(const PG8_LAS bf16x8*)(lds + PG8_SB(b, h) + boff + n * 2048 + k * 1024); } while (0)
#define PG8_MMA(ai, bj, At, Bt) do { __builtin_amdgcn_s_setprio(1); _Pragma("unroll") for (int m = 0; m < 4; ++m) _Pragma("unroll") for (int n = 0; n < 2; ++n) _Pragma("unroll") for (int k = 0; k < 2; ++k) \
        acc[ai][bj][m][n] = mma_op<I8>(Bt[n][k], At[m][k], acc[ai][bj][m][n]); __builtin_amdgcn_s_setprio(0); } while (0)
#define PG8_WAIT_V(n) asm volatile("s_waitcnt vmcnt(" #n ")" ::: "memory")
#define PG8_WAIT_L(n) asm volatile("s_waitcnt lgkmcnt(" #n ")" ::: "memory")
#define PG8_BAR __builtin_amdgcn_s_barrier()
#define PG8_SCHED __builtin_amdgcn_sched_barrier(0)
    Unit cur, nxt; int ui = 0;
    if (!S.next(0, cur)) return;
    f32x4 acc[2][2][4][2];
#pragma unroll
    for (int a = 0; a < 2; ++a)
#pragma unroll
        for (int b = 0; b < 2; ++b)
#pragma unroll
            for (int m = 0; m < 4; ++m)
#pragma unroll
                for (int n = 0; n < 2; ++n) acc[a][b][m][n] = (f32x4){0.f, 0.f, 0.f, 0.f};
    bf16x8 At[4][2], B0[2][2], B1[2][2];
    const char* cA = (const char*)g.A + (size_t)cur.pm * tstep + (size_t)cur.kb * kstep; const char* cB = (const char*)g.Bt + (size_t)cur.pn * tstep + (size_t)cur.kb * kstep;
    S.a_ready(cur);
    if constexpr (SP2) {
        PG8_STAGE(PG8_SB(0, 0), cB, voffB); PG8_STAGE(PG8_SB(0, 1), cB + hstep, voffB); PG8_STAGE(PG8_SA(0, 0), cA, voffA); PG8_STAGE(PG8_SA(0, 1), cA + hstep, voffA);
        if (wr == 1) PG8_BAR;
        PG8_WAIT_V(2); PG8_BAR;
        PG8_STAGE(PG8_SB(1, 0), cB + kstep, voffB); PG8_STAGE(PG8_SA(1, 0), cA + kstep, voffA); PG8_STAGE(PG8_SB(1, 1), cB + hstep + kstep, voffB);
        PG8_WAIT_V(6); PG8_BAR;
    } else {
        PG8_STAGE(PG8_SB(0, 0), cB, voffB); PG8_STAGE(PG8_SA(0, 0), cA, voffA); PG8_STAGE(PG8_SB(0, 1), cB + hstep, voffB); PG8_STAGE(PG8_SA(0, 1), cA + hstep, voffA);
        if (wr == 1) PG8_BAR;
        PG8_WAIT_V(4); PG8_BAR;
        PG8_STAGE(PG8_SB(1, 0), cB + kstep, voffB); PG8_STAGE(PG8_SA(1, 0), cA + kstep, voffA); PG8_STAGE(PG8_SB(1, 1), cB + hstep + kstep, voffB);
        PG8_WAIT_V(6); PG8_BAR;
    }
    for (;;) {
        const bool has_next = S.next(ui + 1, nxt);
        const char* nA = has_next ? (const char*)g.A + (size_t)nxt.pm * tstep + (size_t)nxt.kb * kstep : cA; const char* nB = has_next ? (const char*)g.Bt + (size_t)nxt.pn * tstep + (size_t)nxt.kb * kstep : cB;
        const int unt = cur.nk ? cur.nk : nt;
        for (int t = 0; t < unt; t += 2) {
            const bool last = (t == unt - 2);
            const char* a1 = cA + (size_t)(t + 1) * kstep;
            const char* a2 = last ? nA : cA + (size_t)(t + 2) * kstep; const char* b2 = last ? nB : cB + (size_t)(t + 2) * kstep;
            const char* a3 = a2 + kstep; const char* b3 = b2 + kstep;
            if (last && has_next) S.a_ready(nxt);
            if constexpr (SP2) {
            PG8_LDB(B0, 0, 0); PG8_LDB(B1, 0, 1); PG8_SCHED; PG8_LDA(At, 0, 0); PG8_STAGE(PG8_SA(1, 1), a1 + hstep, voffA);
            PG8_WAIT_V(8); PG8_WAIT_L(0); PG8_BAR; PG8_MMA(0, 0, At, B0); PG8_MMA(0, 1, At, B1); PG8_BAR; PG8_SCHED;
            PG8_LDA(At, 0, 1); PG8_STAGE(PG8_SB(0, 0), b2, voffB); PG8_STAGE(PG8_SB(0, 1), b2 + hstep, voffB); PG8_STAGE(PG8_SA(0, 0), a2, voffA);
            PG8_WAIT_V(8); PG8_WAIT_L(0); PG8_BAR; PG8_MMA(1, 0, At, B0); PG8_MMA(1, 1, At, B1); PG8_BAR; PG8_SCHED;
            PG8_LDB(B0, 1, 0); PG8_LDB(B1, 1, 1); PG8_SCHED; PG8_LDA(At, 1, 0); PG8_STAGE(PG8_SA(0, 1), a2 + hstep, voffA);
            PG8_WAIT_V(8); PG8_WAIT_L(0); PG8_BAR; PG8_MMA(0, 0, At, B0); PG8_MMA(0, 1, At, B1); PG8_BAR; PG8_SCHED;
            PG8_LDA(At, 1, 1); PG8_STAGE(PG8_SB(1, 0), b3, voffB); PG8_STAGE(PG8_SB(1, 1), b3 + hstep, voffB); PG8_STAGE(PG8_SA(1, 0), a3, voffA);
            PG8_WAIT_V(8); PG8_WAIT_L(0); PG8_BAR; PG8_MMA(1, 0, At, B0); PG8_MMA(1, 1, At, B1); PG8_BAR; PG8_SCHED;
            } else {
            PG8_LDB(B0, 0, 0); PG8_SCHED; PG8_LDA(At, 0, 0); PG8_STAGE(PG8_SA(1, 1), a1 + hstep, voffA);
            PG8_WAIT_L(8); PG8_BAR; PG8_WAIT_L(0); PG8_MMA(0, 0, At, B0); PG8_BAR; PG8_SCHED;
            PG8_LDB(B1, 0, 1); PG8_STAGE(PG8_SB(0, 0), b2, voffB);
            PG8_BAR; PG8_WAIT_L(0); PG8_MMA(0, 1, At, B1); PG8_BAR;
            PG8_LDA(At, 0, 1); PG8_STAGE(PG8_SA(0, 0), a2, voffA);
            PG8_BAR; PG8_WAIT_L(0); PG8_MMA(1, 0, At, B0); PG8_BAR; PG8_SCHED;
            PG8_STAGE(PG8_SB(0, 1), b2 + hstep, voffB);
            PG8_WAIT_V(6); PG8_BAR; PG8_MMA(1, 1, At, B1); PG8_BAR;
            PG8_LDB(B0, 1, 0); PG8_SCHED; PG8_LDA(At, 1, 0); PG8_STAGE(PG8_SA(0, 1), a2 + hstep, voffA);
            PG8_WAIT_L(8); PG8_BAR; PG8_WAIT_L(0); PG8_MMA(0, 0, At, B0); PG8_BAR; PG8_SCHED;
            PG8_LDB(B1, 1, 1); PG8_STAGE(PG8_SB(1, 0), b3, voffB);
            PG8_BAR; PG8_WAIT_L(0); PG8_MMA(0, 1, At, B1); PG8_BAR;
            PG8_LDA(At, 1, 1); PG8_STAGE(PG8_SA(1, 0), a3, voffA);
            PG8_BAR; PG8_WAIT_L(0); PG8_MMA(1, 0, At, B0); PG8_BAR; PG8_SCHED;
            PG8_STAGE(PG8_SB(1, 1), b3 + hstep, voffB);
            PG8_WAIT_V(6); PG8_BAR; PG8_MMA(1, 1, At, B1); PG8_BAR;
            }
        }
        if constexpr (ALIGN_EPI) { if (wr == 0) PG8_BAR; }
        if constexpr (!Epi::AFTER_DRAIN) {
            if (Sched::HAS_PARK && cur.part == 1) {
                char* pb = (char*)g.pbuf + tid * 16;
#pragma unroll
                for (int a = 0; a < 2; ++a)
#pragma unroll
                    for (int b = 0; b < 2; ++b)
#pragma unroll
                        for (int m = 0; m < 4; ++m)
#pragma unroll
                            for (int n = 0; n < 2; ++n) { *(f32x4*)pb = acc[a][b][m][n]; pb += 8192; asm volatile("" : "+v"(pb)); }
            } else if (Sched::HAS_MID && cur.part == 3) { E.mid(acc, cur, wr, wc, fr, fq);
            } else { if constexpr (I8) E.dequant(acc, cur, wr, wc, fr, fq); E(acc, cur, wr, wc, fr, fq); S.done(cur); } }
        if (!has_next) break;
        if (Sched::HAS_PARK && nxt.part == 2) {
            const char* pb = (const char*)g.pbuf + tid * 16;
#pragma unroll
            for (int a = 0; a < 2; ++a)
#pragma unroll
                for (int b = 0; b < 2; ++b)
#pragma unroll
                    for (int m = 0; m < 4; ++m)
#pragma unroll
                        for (int n = 0; n < 2; ++n) { acc[a][b][m][n] = *(const f32x4*)pb; pb += 8192; asm volatile("" : "+v"(pb)); }
        } else if (!(Sched::HAS_MID && cur.part == 3))
#pragma unroll
        for (int a = 0; a < 2; ++a)
#pragma unroll
            for (int b = 0; b < 2; ++b)
#pragma unroll
                for (int m = 0; m < 4; ++m)
#pragma unroll
                    for (int n = 0; n < 2; ++n) acc[a][b][m][n] = (f32x4){0.f, 0.f, 0.f, 0.f};
        cur = nxt; cA = nA; cB = nB; ++ui;
        if constexpr (ALIGN_EPI) { if (wr == 1) PG8_BAR; }
    }
    PG8_WAIT_V(0);
    if constexpr (!ALIGN_EPI) { if (wr == 0) PG8_BAR; }
    PG8_BAR;
    if constexpr (Epi::AFTER_DRAIN) { E.fused(acc, cur, wr, wc, fr, fq, lds, wid, lane); S.done(cur); }
#undef PG8_SA
#undef PG8_SB
#undef PG8_STAGE
#undef PG8_LDA
#undef PG8_LDB
#undef PG8_MMA
#undef PG8_WAIT_V
#undef PG8_WAIT_L
#undef PG8_BAR
#undef PG8_SCHED
}
}

constexpr int D = 2048, NBATCH = 16, L = 2048, M = NBATCH * L;
constexpr int MC = 8192, NCH = 4, DEPTH = 2;
constexpr int NIN = 14344, NP = 14336;
constexpr int C_QM = 0, C_KM = 1024, C_VM = 2048, C_OM = 3072, C_QD = 4096, C_KD = 5120, C_VD = 6144, C_US = 7168, C_GATE = 8192;
constexpr int DFF = 5632, NUP = 2 * DFF;
constexpr float EPS = 1e-6f;
constexpr int NWAVES = 8, NTHR = 512;

constexpr size_t MiB = 1u << 20;
constexpr size_t WS_CTL = 0, CTL_ZERO_BYTES = 1 * MiB;
constexpr size_t WS_TAB = 1 * MiB;
constexpr size_t T_WIF = WS_TAB, T_BIAS = WS_TAB + 131072, T_S5A = WS_TAB + 262144, T_BBT = WS_TAB + 524288, T_CT = WS_TAB + 1048576;
constexpr size_t T_SA_FFN = 2560 * 1024, T_SA_MIX = 2688 * 1024, T_SB_UP = 2816 * 1024, T_SB_G = 2880 * 1024, T_ONES = 2944 * 1024, T_LAM = 2945 * 1024;
constexpr size_t WS_XN8F = 150 * MiB + 64 * MiB;
constexpr size_t WS_WIN = 4 * MiB, WS_WGLU = 60 * MiB, WS_WB = 64 * MiB, WS_WOUT = 76 * MiB, WS_WUP = 84 * MiB, WS_WDN = 128 * MiB;
constexpr size_t WS_XN = 150 * MiB, WS_IFG = 278 * MiB;
constexpr size_t WS_PROJ = 280 * MiB, WS_QKC = 504 * MiB, WS_HM = 536 * MiB, WS_O12 = 552 * MiB, WS_YS5 = 584 * MiB, WS_Y = 600 * MiB, WS_MERGED = 648 * MiB;
constexpr size_t WS_XN8M = 776 * MiB;
constexpr size_t WS_WG8 = 4 * MiB + 16 * MiB;
constexpr size_t WS_MIX = 280 * MiB;
constexpr int MH = 16384;
constexpr size_t WS_ACT = 280 * MiB, WS_FFN = 456 * MiB;
constexpr size_t WS_XB = 872 * MiB;
constexpr size_t WS_PBUF = 0;
constexpr size_t WS_RAW = 1000 * MiB;
constexpr size_t WS_END = 1022 * MiB;
static_assert(WS_WIN + (size_t)NP * D * 2 <= WS_WGLU && WS_WGLU + (size_t)2048 * 1024 * 2 <= WS_WB && WS_WB + (size_t)3 * 2048 * 1024 * 2 <= WS_WOUT && WS_WOUT + (size_t)D * D * 2 <= WS_WUP && WS_WUP + (size_t)NUP * D * 2 <= WS_WDN && WS_WDN + (size_t)D * DFF * 2 <= WS_XN, "ws map: weights");
static_assert(WS_XN + (size_t)M * D * 2 <= WS_IFG && WS_PROJ + (size_t)MC * NP * 2 <= WS_QKC && WS_Y + (size_t)3 * MC * 1024 * 2 <= WS_MERGED && WS_MERGED + (size_t)M * D * 2 <= WS_XN8M, "ws map: mixer");
static_assert(WS_MIX + (size_t)M * D * 2 <= WS_MERGED && WS_ACT + (size_t)MH * DFF * 2 <= WS_FFN && WS_FFN + (size_t)MH * D * 2 <= WS_XN8M && WS_XN8M + (size_t)M * D <= WS_XB && WS_XB + (size_t)M * D * 2 <= WS_END, "ws map: ffn");
constexpr int CW_QUEUE = 64;
constexpr int CW_BAR = 4096;
constexpr int CW_COLMAX = 65536, NI8 = 10240;

constexpr int LDS_BYTES = 147456, LDSCTL_OFF = 143360;

#define GAS __attribute__((address_space(1)))
#define LAS __attribute__((address_space(3)))
#define DI __device__ __forceinline__
typedef unsigned short bf16;
typedef unsigned v4u __attribute__((ext_vector_type(4)));
typedef unsigned v2u __attribute__((ext_vector_type(2)));
typedef float f32x4 __attribute__((ext_vector_type(4)));
typedef float f32x2 __attribute__((ext_vector_type(2)));
typedef short bf16x8 __attribute__((ext_vector_type(8)));
typedef short s16x4 __attribute__((ext_vector_type(4)));
typedef GAS unsigned gu32;
#define RLX_AGENT __ATOMIC_RELAXED, __HIP_MEMORY_SCOPE_AGENT
#define LDS_WAIT() asm volatile("s_waitcnt lgkmcnt(0)" ::: "memory")
#ifdef P0_NT_LD
#define P0_LD(p_) __builtin_nontemporal_load(p_)
#else
#define P0_LD(p_) (*(p_))
#endif
#define VM_WAIT() asm volatile("s_waitcnt vmcnt(0)" ::: "memory")
#define MFMA16(a, b, c) __builtin_amdgcn_mfma_f32_16x16x32_bf16((a), (b), (c), 0, 0, 0)
#define SB() __builtin_amdgcn_sched_barrier(0)
#ifndef NOSB1
#define SB1() SB()
#else
#define SB1()
#endif
#if 0
#define SB2() SB()
#else
#define SB2()
#endif
#ifndef NOSB3
#define SB3() SB()
#else
#define SB3()
#endif
DI unsigned f2bf(float f) { unsigned u = __builtin_bit_cast(unsigned, f); return (u + 0x7fffu + ((u >> 16) & 1u)) >> 16; }
DI unsigned pk2(float lo, float hi) { return pg8::cvt_pk_bf16(lo, hi); }
DI float bflo(unsigned w) { return __uint_as_float(w << 16); }
DI float bfhi(unsigned w) { return __uint_as_float(w & 0xffff0000u); }
DI float bf2f(bf16 b) { return __uint_as_float(((unsigned)b) << 16); }
DI float ex2(float x) { return __builtin_amdgcn_exp2f(x); }
DI float expf_(float x) { return __builtin_amdgcn_exp2f(x * 1.4426950409f); }
DI float sigm(float x) { return __builtin_amdgcn_rcpf(1.0f + __builtin_amdgcn_exp2f(-1.4426950409f * x)); }
DI float gelu_tanh(float a) { const float u = a * (1.0f + 0.044715f * a * a); return a * sigm(1.5957691216f * u); }
DI float wave_sum(float v) {
#pragma unroll
    for (int o = 1; o < 64; o <<= 1) v += __shfl_xor(v, o);
    return v;
}
DI float wave_max(float v) {
#pragma unroll
    for (int o = 1; o < 64; o <<= 1) v = fmaxf(v, __shfl_xor(v, o));
    return v;
}
DI unsigned pack_i8(f32x4 v, float inv) {
    const int a = (int)__builtin_rintf(v.x * inv), b = (int)__builtin_rintf(v.y * inv), c = (int)__builtin_rintf(v.z * inv), d = (int)__builtin_rintf(v.w * inv);
    return (unsigned)(a & 255) | ((unsigned)(b & 255) << 8) | ((unsigned)(c & 255) << 16) | ((unsigned)d << 24);
}
DI bf16x8 tr8(const LAS unsigned char* p0, const LAS unsigned char* p1) {
    typedef short v4i16_t __attribute__((ext_vector_type(4)));
    const s16x4 lo = __builtin_bit_cast(s16x4, __builtin_amdgcn_ds_read_tr16_b64_v4i16((LAS v4i16_t*)p0));
    const s16x4 hi = __builtin_bit_cast(s16x4, __builtin_amdgcn_ds_read_tr16_b64_v4i16((LAS v4i16_t*)p1));
    return __builtin_shufflevector(lo, hi, 0, 1, 2, 3, 4, 5, 6, 7);
}

struct Frame {
    LAS unsigned char* lds;
    volatile LAS unsigned* MISC;
    gu32* ctl;
    int tid, lane, wave, G, bid;
    unsigned char* ws;
    const float* const* in;
    float* out;
};

DI void p0_transpose_item(const float* W, int ldw, int K, int src_col0, bf16* WT, int dst_row0, LAS float* scr, int kb, int lane) {
    const int k0 = 64 * kb, kr = lane >> 3, nc = lane & 7;
    f32x4 v[8];
#pragma unroll
    for (int i = 0; i < 8; ++i) v[i] = P0_LD((const GAS f32x4*)(W + (size_t)(k0 + kr + 8 * i) * ldw + src_col0 + 4 * nc));
#pragma unroll
    for (int i = 0; i < 8; ++i) *(LAS f32x4*)(scr + (kr + 8 * i) * 36 + 4 * nc) = v[i];
    LDS_WAIT(); asm volatile("" ::: "memory");
    const int c = lane & 7;
#pragma unroll
    for (int j = 0; j < 4; ++j) { const int n = (lane >> 3) + 8 * j; const LAS float* s = scr + (8 * c) * 36 + n;
        v4u o; o.x = pk2(s[0 * 36], s[1 * 36]); o.y = pk2(s[2 * 36], s[3 * 36]); o.z = pk2(s[4 * 36], s[5 * 36]); o.w = pk2(s[6 * 36], s[7 * 36]);
        *(GAS v4u*)(WT + (size_t)(dst_row0 + n) * K + k0 + 8 * c) = o; }
    LDS_WAIT(); asm volatile("" ::: "memory");
}
DI void rms_row_to_bf16(const float* xrow, const float* gain, bf16* orow, int lane, unsigned char* o8 = nullptr, float* sa = nullptr) {
    f32x4 v[8]; float s = 0.f;
#pragma unroll
    for (int j = 0; j < 8; ++j) { v[j] = __builtin_nontemporal_load((const GAS f32x4*)(xrow + 4 * (lane + 64 * j))); s += (v[j].x * v[j].x + v[j].y * v[j].y) + (v[j].z * v[j].z + v[j].w * v[j].w); }
    const float rstd = 1.0f / sqrtf(wave_sum(s) * (1.0f / D) + EPS);
#pragma unroll
    for (int j = 0; j < 8; ++j) { const f32x4 g0 = *(const GAS f32x4*)(gain + 4 * (lane + 64 * j)); const f32x4 a = v[j] * rstd * g0; v[j] = a;
        __builtin_nontemporal_store(((v2u){pk2(a.x, a.y), pk2(a.z, a.w)}), (GAS v2u*)(orow + 4 * (lane + 64 * j))); }
    if (o8) { float mx = 0.f;
#pragma unroll
        for (int j = 0; j < 8; ++j) mx = fmaxf(fmaxf(mx, fmaxf(fabsf(v[j].x), fabsf(v[j].y))), fmaxf(fabsf(v[j].z), fabsf(v[j].w)));
        mx = wave_max(mx); const float inv = mx > 0.f ? 127.0f / mx : 0.f;
#pragma unroll
        for (int j = 0; j < 8; ++j) __builtin_nontemporal_store(pack_i8(v[j], inv), (GAS unsigned*)(o8 + 4 * (lane + 64 * j)));
        if (lane == 0) *sa = mx * (1.0f / 127.0f); }
}
DI void p0_colmax_item(const float* W, int ldw, int src_col0, unsigned* cmax, int dst_row0, int kb, int lane) {
    const int k0 = 64 * kb, kr = lane >> 3, nc = lane & 7;
    f32x4 mx = (f32x4){0.f, 0.f, 0.f, 0.f};
#pragma unroll
    for (int i = 0; i < 8; ++i) { const f32x4 v = *(const GAS f32x4*)(W + (size_t)(k0 + kr + 8 * i) * ldw + src_col0 + 4 * nc);
        mx.x = fmaxf(mx.x, fabsf(v.x)); mx.y = fmaxf(mx.y, fabsf(v.y)); mx.z = fmaxf(mx.z, fabsf(v.z)); mx.w = fmaxf(mx.w, fabsf(v.w)); }
#pragma unroll
    for (int o = 8; o < 64; o <<= 1) { mx.x = fmaxf(mx.x, __shfl_xor(mx.x, o)); mx.y = fmaxf(mx.y, __shfl_xor(mx.y, o)); mx.z = fmaxf(mx.z, __shfl_xor(mx.z, o)); mx.w = fmaxf(mx.w, __shfl_xor(mx.w, o)); }
    if (lane < 8) { unsigned* p = cmax + dst_row0 + 4 * nc;
        atomicMax(p, __float_as_uint(mx.x)); atomicMax(p + 1, __float_as_uint(mx.y)); atomicMax(p + 2, __float_as_uint(mx.z)); atomicMax(p + 3, __float_as_uint(mx.w)); }
}
DI void p0_transpose_i8_item(const float* W, int ldw, int K, int src_col0, signed char* WT, const unsigned* cmax, int dst_row0, LAS float* scr, int kb, int lane) {
    const int k0 = 64 * kb, kr = lane >> 3, nc = lane & 7;
    f32x4 v[8];
#pragma unroll
    for (int i = 0; i < 8; ++i) v[i] = *(const GAS f32x4*)(W + (size_t)(k0 + kr + 8 * i) * ldw + src_col0 + 4 * nc);
#pragma unroll
    for (int i = 0; i < 8; ++i) *(LAS f32x4*)(scr + (kr + 8 * i) * 36 + 4 * nc) = v[i];
    LDS_WAIT(); asm volatile("" ::: "memory");
    const int c = lane & 7;
#pragma unroll
    for (int j = 0; j < 4; ++j) { const int n = (lane >> 3) + 8 * j; const LAS float* s = scr + (8 * c) * 36 + n;
        const float cm = __uint_as_float(cmax[dst_row0 + n]), inv = cm > 0.f ? 127.0f / cm : 0.f;
        v2u o; o.x = pack_i8((f32x4){s[0 * 36], s[1 * 36], s[2 * 36], s[3 * 36]}, inv); o.y = pack_i8((f32x4){s[4 * 36], s[5 * 36], s[6 * 36], s[7 * 36]}, inv);
        *(GAS v2u*)(WT + (size_t)(dst_row0 + n) * K + k0 + 8 * c) = o; }
    LDS_WAIT(); asm volatile("" ::: "memory");
}
DI void p0_strip_i8(Frame& F, const float* W, int ldw, int src_col0, signed char* WT, float* sb, int dst_row0) {
    const int lane = F.lane, w = F.wave, kr = lane >> 3, nc = lane & 7;
    LAS float* scr = (LAS float*)(F.lds + w * 16384); LAS float* cmx = (LAS float*)(F.lds + 131072);
    f32x4 v[4][8];
    const unsigned off0 = (unsigned)((256 * w + kr) * ldw + src_col0 + 4 * nc) * 4u;
#pragma unroll
    for (int j = 0; j < 4; ++j)
#pragma unroll
        for (int i = 0; i < 8; ++i) v[j][i] = P0_LD((const GAS f32x4*)((const char*)W + (off0 + (unsigned)((64 * j + 8 * i) * ldw) * 4u)));
    f32x4 mx = (f32x4){0.f, 0.f, 0.f, 0.f};
#pragma unroll
    for (int j = 0; j < 4; ++j)
#pragma unroll
        for (int i = 0; i < 8; ++i) { mx.x = fmaxf(mx.x, fabsf(v[j][i].x)); mx.y = fmaxf(mx.y, fabsf(v[j][i].y)); mx.z = fmaxf(mx.z, fabsf(v[j][i].z)); mx.w = fmaxf(mx.w, fabsf(v[j][i].w)); }
#pragma unroll
    for (int o = 8; o < 64; o <<= 1) { mx.x = fmaxf(mx.x, __shfl_xor(mx.x, o)); mx.y = fmaxf(mx.y, __shfl_xor(mx.y, o)); mx.z = fmaxf(mx.z, __shfl_xor(mx.z, o)); mx.w = fmaxf(mx.w, __shfl_xor(mx.w, o)); }
    if (lane < 8) *(LAS f32x4*)(cmx + w * 32 + 4 * nc) = mx;
    __syncthreads();
    float inv[4];
#pragma unroll
    for (int j = 0; j < 4; ++j) { const int n = (lane >> 3) + 8 * j; float cm = 0.f;
#pragma unroll
        for (int ww = 0; ww < 8; ++ww) cm = fmaxf(cm, cmx[ww * 32 + n]);
        inv[j] = cm > 0.f ? 127.0f / cm : 0.f;
        if (w == 0 && (lane & 7) == 0) sb[dst_row0 + n] = cm * (1.0f / 127.0f); }
    const int c = lane & 7;
#pragma unroll
    for (int j4 = 0; j4 < 4; ++j4) {
#pragma unroll
        for (int i = 0; i < 8; ++i) *(LAS f32x4*)(scr + (kr + 8 * i) * 36 + 4 * nc) = v[j4][i];
        LDS_WAIT(); asm volatile("" ::: "memory");
#pragma unroll
        for (int j = 0; j < 4; ++j) { const int n = (lane >> 3) + 8 * j; const LAS float* sp = scr + (8 * c) * 36 + n;
            v2u o; o.x = pack_i8((f32x4){sp[0 * 36], sp[1 * 36], sp[2 * 36], sp[3 * 36]}, inv[j]); o.y = pack_i8((f32x4){sp[4 * 36], sp[5 * 36], sp[6 * 36], sp[7 * 36]}, inv[j]);
            *(GAS v2u*)((char*)WT + (unsigned)((dst_row0 + n) * D + 256 * w + 64 * j4 + 8 * c)) = o; }
        LDS_WAIT(); asm volatile("" ::: "memory"); }
    __syncthreads();
}
DI void p0_weights(Frame& F, int l) {
    for (int sidx = F.bid; sidx < NUP / 32 + NI8 / 32; sidx += F.G) {
        if (sidx < NUP / 32) { const int n0 = 32 * sidx, cc = n0 >= DFF ? n0 - DFF : n0, drow = (cc >> 7) * 256 + (n0 >= DFF ? 128 : 0) + (cc & 127);
            p0_strip_i8(F, F.in[23] + (size_t)l * D * NUP, NUP, n0, (signed char*)(F.ws + WS_WUP), (float*)(F.ws + T_SB_UP), drow); }
        else { const int r8 = 32 * (sidx - NUP / 32);
            int n0 = r8 < 2048 ? r8 + 2048 : r8 + 4096;
            if (r8 >= 4096 && r8 < 8192) { const int q = r8 - 4096, ww = q & 255; n0 = C_GATE + (ww >> 7) * 2048 + 128 * (q >> 8) + (ww & 127); }
            const int oc = n0 < 4096 ? n0 : n0 + 8;
            p0_strip_i8(F, F.in[5] + (size_t)l * D * NIN, NIN, oc, (signed char*)(F.ws + WS_WG8), (float*)(F.ws + T_SB_G), r8); }
    }
    LAS float* scr = (LAS float*)(F.lds + F.wave * 16384);
    const int gw = F.bid * NWAVES + F.wave, NGW = F.G * NWAVES;
    constexpr int I_IN = 32 * 128, I_GLU = 16 * 64, I_B = 3 * 16 * 64, I_OUT = 32 * 64, I_DN = 88 * 64, I_LAYER = I_IN + I_GLU + I_B + I_OUT + I_DN;
    for (int it = gw; it < I_LAYER; it += NGW) {
        int r = it;
        if (r < I_IN) { const int kb = r / 128, nb = r % 128, nd = 32 * nb, n0 = nd < 2048 ? nd : nd + 2048;
            const int oc = n0 < 4096 ? n0 : n0 + 8;
            p0_transpose_item(F.in[5] + (size_t)l * D * NIN, NIN, D, oc, (bf16*)(F.ws + WS_WIN), nd, scr, kb, F.lane);
            continue; } r -= I_IN;
        if (r < I_GLU) { const int kb = r / 64, nb = r % 64, n0 = 32 * nb; const int cc = n0 & 1023, drow = (cc >> 7) * 256 + (n0 >= 1024 ? 128 : 0) + (cc & 127);
            p0_transpose_item(F.in[20] + (size_t)l * 1024 * 2048, 2048, 1024, n0, (bf16*)(F.ws + WS_WGLU), drow, scr, kb, F.lane); continue; } r -= I_GLU;
        if (r < I_B) { const int n = r / 1024, rr = r % 1024, kb = rr / 64, nb = rr % 64;
            p0_transpose_item(F.in[21] + (size_t)(l * 3 + n) * 1024 * 2048, 2048, 1024, 32 * nb, (bf16*)(F.ws + WS_WB) + (size_t)n * 2048 * 1024, 32 * nb, scr, kb, F.lane); continue; } r -= I_B;
        if (r < I_OUT) { const int kb = r / 64, nb = r % 64;
            p0_transpose_item(F.in[22] + (size_t)l * D * D, D, D, 32 * nb, (bf16*)(F.ws + WS_WOUT), 32 * nb, scr, kb, F.lane); continue; } r -= I_OUT;
        { const int kb = r / 64, nb = r % 64;
            p0_transpose_item(F.in[26] + (size_t)l * DFF * D, D, DFF, 32 * nb, (bf16*)(F.ws + WS_WDN), 32 * nb, scr, kb, F.lane); }
    }
}
DI void p0_tables(Frame& F) {
    const int gw = F.bid * NWAVES + F.wave, NGW = F.G * NWAVES;
    const int gt = F.bid * NTHR + F.tid, NGT = F.G * NTHR;
    if (gt < 4) ((unsigned*)(F.ws + T_ONES))[gt] = 0x3F803F80u;
    if (gw < DEPTH) { const int lane = F.lane; const float* lam = F.in[9] + gw * 4 * 128;
        const float s01 = wave_sum(lam[lane] * lam[128 + lane] + lam[64 + lane] * lam[192 + lane]);
        const float s23 = wave_sum(lam[256 + lane] * lam[384 + lane] + lam[320 + lane] * lam[448 + lane]);
        const float lambda_init = 0.8f - 0.6f * expf(-0.3f * (float)gw);
        if (lane == 0) { ((float*)(F.ws + T_LAM))[2 * gw] = expf(s01) - expf(s23) + lambda_init; ((float*)(F.ws + T_LAM))[2 * gw + 1] = 1.0f - lambda_init; } }
    for (int i = gt; i < DEPTH * 8 * D; i += NGT) { const int l = i / (8 * D), j = (i / D) & 7, d = i % D;
        ((float*)(F.ws + T_WIF))[i] = F.in[5][((size_t)l * D + d) * NIN + 4096 + j]; }
    for (int i = gt; i < 4 * 128; i += NGT) { const int h = i >> 7, n = i & 127;
        int bk = n; if (n >= 16) { bk = 16 + (int)(logf((float)n / 16.0f) / 2.0794415416798357f * 16.0f); bk = bk < 31 ? bk : 31; }
        ((float*)(F.ws + T_BIAS))[i] = F.in[11][bk * 4 + h] * 1.4426950409f; }
    for (int i = gt; i < DEPTH * 64 * 64; i += NGT) {
        const int l = i >> 12, g = (i >> 6) & 63, p = i & 63;
        const float lr = F.in[12][i], li = F.in[13][i], dt = expf(F.in[14][l * 64 + g]);
        const float mag = expf(lr * dt), are = mag * cosf(li * dt), aim = mag * sinf(li * dt), den = lr * lr + li * li;
        const float zre = ((are - 1.0f) * lr + aim * li) / den, zim = (aim * lr - (are - 1.0f) * li) / den;
        ((float*)(F.ws + T_S5A))[2 * i] = are; ((float*)(F.ws + T_S5A))[2 * i + 1] = aim;
        bf16* bbt = (bf16*)(F.ws + T_BBT) + ((size_t)(l * 64 + g) * 128 + 2 * p) * 16;
        bf16* ct = (bf16*)(F.ws + T_CT) + (size_t)(l * 64 + g) * 16 * 128;
        for (int c = 0; c < 16; ++c) { const float br = F.in[15][(size_t)i * 16 + c], bi = F.in[16][(size_t)i * 16 + c];
            bbt[c] = (bf16)f2bf(zre * br - zim * bi); bbt[16 + c] = (bf16)f2bf(zre * bi + zim * br);
            const size_t ci = ((size_t)(l * 64 + g) * 16 + c) * 64 + p;
            ct[c * 128 + 2 * p] = (bf16)f2bf(F.in[17][ci]); ct[c * 128 + 2 * p + 1] = (bf16)f2bf(-F.in[18][ci]); }
    }
    for (int m = gw; m < M; m += NGW) rms_row_to_bf16(F.in[0] + (size_t)m * D, F.in[1], (bf16*)(F.ws + WS_XN) + (size_t)m * D, F.lane, F.ws + WS_XN8M + (size_t)m * D, (float*)(F.ws + T_SA_MIX) + m);
}

DI void p2_conv_gates(Frame& F, int layer, int chunk) {
    const bf16* proj = (const bf16*)(F.ws + WS_PROJ); bf16* qkc = (bf16*)(F.ws + WS_QKC);
    const float* cw = F.in[7] + (size_t)layer * 4 * 2048;
    LAS float* wl = (LAS float*)F.lds;
    { const float* wif = (const float*)(F.ws + T_WIF) + (size_t)layer * 8 * D;
      for (int i = F.tid; i < 8 * D / 4; i += NTHR) ((LAS f32x4*)wl)[i] = ((const GAS f32x4*)wif)[i]; }
    const int gt = F.bid * NTHR + F.tid, NGT = F.G * NTHR;
    for (int task = gt; task < 256 * 512; task += NGT) {
        const int co = task & 255, run = task >> 8, r0 = run * 16, t0 = r0 & (L - 1), c = 8 * co;
        f32x4 w[4][2];
#pragma unroll
        for (int j = 0; j < 4; ++j) { w[j][0] = *(const GAS f32x4*)(cw + j * 2048 + c); w[j][1] = *(const GAS f32x4*)(cw + j * 2048 + c + 4); }
        const float post = c >= 1024 ? 0.0625f : 1.0f;
        v4u h[3];
#pragma unroll
        for (int j = 0; j < 3; ++j) { h[j] = (v4u){0u, 0u, 0u, 0u}; if (t0 > 0) h[j] = *(const GAS v4u*)(proj + (size_t)(r0 - 3 + j) * NP + c); }
#pragma unroll
        for (int tb = 0; tb < 16; tb += 8) {
          v4u w8[8];
#pragma unroll
          for (int u = 0; u < 8; ++u) w8[u] = *(const GAS v4u*)(proj + (size_t)(r0 + tb + u) * NP + c);
#pragma unroll
          for (int u = 0; u < 8; ++u) { const v4u x = w8[u]; unsigned o[4];
#pragma unroll
            for (int q = 0; q < 4; ++q) {
                const float a0 = bflo(h[0][q]), a1 = bflo(h[1][q]), a2 = bflo(h[2][q]), x0 = bflo(x[q]);
                const float b0 = bfhi(h[0][q]), b1 = bfhi(h[1][q]), b2 = bfhi(h[2][q]), x1 = bfhi(x[q]);
                const int e = 2 * q, hv = e >> 2, ev = e & 3;
                float y0 = w[0][hv][ev] * a0 + w[1][hv][ev] * a1 + w[2][hv][ev] * a2 + w[3][hv][ev] * x0;
                float y1 = w[0][hv][ev + 1] * b0 + w[1][hv][ev + 1] * b1 + w[2][hv][ev + 1] * b2 + w[3][hv][ev + 1] * x1;
                y0 = y0 * sigm(y0) * post; y1 = y1 * sigm(y1) * post;
                o[q] = pk2(y0, y1); }
            *(GAS v4u*)(qkc + (size_t)(r0 + tb + u) * 2048 + c) = (v4u){o[0], o[1], o[2], o[3]};
            h[0] = h[1]; h[1] = h[2]; h[2] = x; }
        }
    }
    __syncthreads();
    const bf16* xn = (const bf16*)(F.ws + WS_XN) + (size_t)chunk * MC * D; float* ifg = (float*)(F.ws + WS_IFG) + (size_t)chunk * MC * 8;
    const float* bif = F.in[6] + layer * 8;
    const int gw = F.bid * NWAVES + F.wave, NGW = F.G * NWAVES;
    for (int r = gw; r < MC; r += NGW) {
        float x[32];
#pragma unroll
        for (int j = 0; j < 4; ++j) { const v4u w = *(const GAS v4u*)(xn + (size_t)r * D + 8 * (F.lane + 64 * j));
            x[8 * j] = bflo(w.x); x[8 * j + 1] = bfhi(w.x); x[8 * j + 2] = bflo(w.y); x[8 * j + 3] = bfhi(w.y); x[8 * j + 4] = bflo(w.z); x[8 * j + 5] = bfhi(w.z); x[8 * j + 6] = bflo(w.w); x[8 * j + 7] = bfhi(w.w); }
        float res = 0.f;
#pragma unroll 1
        for (int jg = 0; jg < 8; ++jg) { float s = 0.f;
#pragma unroll
            for (int j = 0; j < 4; ++j) { const f32x4 wa = *(const LAS f32x4*)(wl + jg * D + 8 * (F.lane + 64 * j)), wb = *(const LAS f32x4*)(wl + jg * D + 8 * (F.lane + 64 * j) + 4);
                s += x[8 * j] * wa.x + x[8 * j + 1] * wa.y + x[8 * j + 2] * wa.z + x[8 * j + 3] * wa.w + x[8 * j + 4] * wb.x + x[8 * j + 5] * wb.y + x[8 * j + 6] * wb.z + x[8 * j + 7] * wb.w; }
            s = wave_sum(s); if (F.lane == jg) res = s + bif[jg]; }
        if (F.lane < 8) ifg[(size_t)r * 8 + F.lane] = res;
    }
    __syncthreads();
}

constexpr int ML_QS = 0, ML_KS = 33792, ML_VX = 67584, ML_VW = 77824, ML_SS = 88064, ML_CT = 97280, ML_GT = 139520;
constexpr int ML_P = 528, ML_VP = 160, ML_SP = 144;
DI void mlstm_item(Frame& F, int chunk, int item) {
    const int bl = item >> 4, h = (item >> 2) & 3, sl = item & 3;
    const int lrow0 = bl * L; const size_t grow0 = (size_t)chunk * MC + lrow0;
    const bf16* proj = (const bf16*)(F.ws + WS_PROJ); const bf16* qkc = (const bf16*)(F.ws + WS_QKC); const float* ifg = (const float*)(F.ws + WS_IFG);
    bf16* hm = (bf16*)(F.ws + WS_HM);
    LAS unsigned char* lds = F.lds;
    LAS float* gd = (LAS float*)(lds + ML_GT); LAS float* gM = gd + 64; LAS float* gwt = gd + 128; LAS float* gem = gd + 192;
    const int tid = F.tid, lane = F.lane, w = F.wave, fr = lane & 15, fq = lane >> 4, q4 = fr >> 2, p4 = fr & 3;
    constexpr float LOG2E = 1.4426950408889634f, LN2 = 0.6931471805599453f;
    { unsigned z0 = 0u; asm volatile("" : "+v"(z0));
      for (int i = tid; i < 42240 / 16; i += NTHR) ((LAS v4u*)(lds + ML_CT))[i] = (v4u){z0, z0, z0, z0}; }
    f32x4 Cacc[5][2];
#pragma unroll
    for (int a = 0; a < 5; ++a)
#pragma unroll
        for (int b = 0; b < 2; ++b) Cacc[a][b] = (f32x4){0.f, 0.f, 0.f, 0.f};
    float m_prev = 0.f;
    v4u rq[4], rk[4], rv; float ripre, rfpre;
#define ML_LOAD_KV(t0_) do { ripre = ifg[(grow0 + (t0_) + lane) * 8 + h]; rfpre = ifg[(grow0 + (t0_) + lane) * 8 + 4 + h]; \
        _Pragma("unroll") for (int i = 0; i < 4; ++i) { const int q = tid + NTHR * i, s = q >> 5, c16 = q & 31; rk[i] = *(const GAS v4u*)(qkc + (size_t)(lrow0 + (t0_) + s) * 2048 + 1024 + h * 256 + 8 * c16); } \
        { const int s = tid >> 3, c8 = tid & 7; rv = *(const GAS v4u*)(proj + (size_t)(lrow0 + (t0_) + s) * NP + C_VM + h * 256 + sl * 64 + 8 * c8); } } while (0)
#define ML_LOAD_Q(t0_) do { _Pragma("unroll") for (int i = 0; i < 4; ++i) { const int q = tid + NTHR * i, s = q >> 5, c16 = q & 31; rq[i] = *(const GAS v4u*)(qkc + (size_t)(lrow0 + (t0_) + s) * 2048 + h * 256 + 8 * c16); } } while (0)
    ML_LOAD_KV(0); ML_LOAD_Q(0);
    for (int c = 0; c < L / 64; ++c) {
        const int t0 = 64 * c;
        const float ipre = ripre, fpre = rfpre;
        const float lf = fminf(fpre, 0.f) - LN2 * __builtin_amdgcn_logf(1.0f + ex2(-LOG2E * fabsf(fpre)));
        float b = lf;
#pragma unroll
        for (int o = 1; o < 64; o <<= 1) { const float v = __shfl_up(b, o); if (lane >= o) b += v; }
        const float dd = ipre - b; float pm = dd;
#pragma unroll
        for (int o = 1; o < 64; o <<= 1) { const float v = __shfl_up(pm, o); if (lane >= o) pm = fmaxf(pm, v); }
        const float Mt = fmaxf(m_prev, pm), wt = ex2(LOG2E * (m_prev - Mt)), em = ex2(-LOG2E * (b + Mt));
        const float M63 = __shfl(Mt, 63), g = __shfl(b, 63), wsv = ex2(LOG2E * (dd - M63)), decay = ex2(LOG2E * (m_prev - M63));
        if (w == 0) { gd[lane] = dd * LOG2E; gM[lane] = Mt * LOG2E; gwt[lane] = wt; gem[lane] = em; }
#pragma unroll
        for (int i = 0; i < 4; ++i) { const int q = tid + NTHR * i, s = q >> 5, c16 = q & 31;
            *(LAS v4u*)(lds + ML_QS + s * ML_P + 16 * c16) = rq[i]; *(LAS v4u*)(lds + ML_KS + s * ML_P + 16 * c16) = rk[i]; }
        { const int s = tid >> 3, c8 = tid & 7; const float wss = __shfl(wsv, s & 63);
          const v4u v = rv;
          *(LAS v4u*)(lds + ML_VX + s * ML_VP + 16 * c8) = v;
          v4u o; o.x = pk2(bflo(v.x) * wss, bfhi(v.x) * wss); o.y = pk2(bflo(v.y) * wss, bfhi(v.y) * wss); o.z = pk2(bflo(v.z) * wss, bfhi(v.z) * wss); o.w = pk2(bflo(v.w) * wss, bfhi(v.w) * wss);
          *(LAS v4u*)(lds + ML_VW + s * ML_VP + 16 * c8) = o; }
        if (w == 0) { const int s = lane; unsigned z = 0u; asm volatile("" : "+v"(z));
            *(LAS v4u*)(lds + ML_VX + s * ML_VP + 128) = (v4u){0x3F80u | z, z, z, z}; *(LAS v4u*)(lds + ML_VX + s * ML_VP + 144) = (v4u){z, z, z, z};
            *(LAS v4u*)(lds + ML_VW + s * ML_VP + 128) = (v4u){pk2(wsv, 0.f), z, z, z}; *(LAS v4u*)(lds + ML_VW + s * ML_VP + 144) = (v4u){z, z, z, z}; }
        if (c + 1 < L / 64) ML_LOAD_KV(t0 + 64);
        __syncthreads();
        { const int tb = w >> 1, sb0 = 2 * (w & 1);
          if (sb0 <= tb) {
            const bool two = (sb0 + 1) <= tb;
            const float mt = gM[16 * tb + fr];
            const f32x4 d0 = *(const LAS f32x4*)(gd + 16 * sb0 + 4 * fq), d1 = *(const LAS f32x4*)(gd + 16 * (sb0 + 1) + 4 * fq);
            f32x4 a0 = (f32x4){0.f, 0.f, 0.f, 0.f}, a1 = a0;
#pragma unroll
            for (int hk = 0; hk < 2; ++hk) {
                bf16x8 qa[4], ka[4], kc[4];
#pragma unroll
                for (int k4 = 0; k4 < 4; ++k4) { const int ks = 4 * hk + k4;
                    qa[k4] = *(const LAS bf16x8*)(lds + ML_QS + (16 * tb + fr) * ML_P + (32 * ks + 8 * fq) * 2);
                    ka[k4] = *(const LAS bf16x8*)(lds + ML_KS + (16 * sb0 + fr) * ML_P + (32 * ks + 8 * fq) * 2);
                    kc[k4] = *(const LAS bf16x8*)(lds + ML_KS + (16 * (sb0 + 1) + fr) * ML_P + (32 * ks + 8 * fq) * 2); }
                SB1();
#pragma unroll
                for (int k4 = 0; k4 < 4; ++k4) { a0 = MFMA16(ka[k4], qa[k4], a0); a1 = MFMA16(kc[k4], qa[k4], a1); }
                SB1(); }
            const int t = 16 * tb + fr;
            { const int s0 = 16 * sb0 + 4 * fq; float v[4];
#pragma unroll
              for (int i = 0; i < 4; ++i) v[i] = (s0 + i <= t) ? a0[i] * ex2(d0[i] - mt) : 0.f;
              *(LAS v2u*)(lds + ML_SS + t * ML_SP + 2 * s0) = (v2u){pk2(v[0], v[1]), pk2(v[2], v[3])}; }
            { const int s0 = 16 * (sb0 + 1) + 4 * fq; float v[4];
#pragma unroll
              for (int i = 0; i < 4; ++i) v[i] = (two && s0 + i <= t) ? a1[i] * ex2(d1[i] - mt) : 0.f;
              *(LAS v2u*)(lds + ML_SS + t * ML_SP + 2 * s0) = (v2u){pk2(v[0], v[1]), pk2(v[2], v[3])}; }
          } else {
            const int t = 16 * tb + fr;
            *(LAS v2u*)(lds + ML_SS + t * ML_SP + 2 * (16 * sb0 + 4 * fq)) = (v2u){0u, 0u}; *(LAS v2u*)(lds + ML_SS + t * ML_SP + 2 * (16 * (sb0 + 1) + 4 * fq)) = (v2u){0u, 0u};
          } }
        __syncthreads();
        { const int tb = w & 3, half = w >> 2, t = 16 * tb + fr;
          bf16x8 qf[8], sf[2], ca[8], vx[2];
          f32x4 qc[3], sv[3];
#pragma unroll
          for (int ks = 0; ks < 8; ++ks) qf[ks] = *(const LAS bf16x8*)(lds + ML_QS + t * ML_P + (32 * ks + 8 * fq) * 2);
#pragma unroll
          for (int ks = 0; ks < 2; ++ks) sf[ks] = *(const LAS bf16x8*)(lds + ML_SS + t * ML_SP + (32 * ks + 8 * fq) * 2);
          const float wt_t = gwt[t], em_t = gem[t];
#pragma unroll
          for (int j = 0; j < 3; ++j) { const int vb = (j == 2) ? 4 : (2 * half + j);
#pragma unroll
              for (int ks = 0; ks < 8; ++ks) ca[ks] = *(const LAS bf16x8*)(lds + ML_CT + (16 * vb + fr) * ML_P + (32 * ks + 8 * fq) * 2);
#pragma unroll
              for (int ks = 0; ks < 2; ++ks) { const LAS unsigned char* p0 = lds + ML_VX + (32 * ks + 8 * fq + q4) * ML_VP + (16 * vb + 4 * p4) * 2; vx[ks] = tr8(p0, p0 + 4 * ML_VP); }
              SB2();
              f32x4 a = (f32x4){0.f, 0.f, 0.f, 0.f}, b2 = a;
#pragma unroll
              for (int ks = 0; ks < 2; ++ks) b2 = MFMA16(vx[ks], sf[ks], b2);
#pragma unroll
              for (int ks = 0; ks < 8; ++ks) a = MFMA16(ca[ks], qf[ks], a);
              qc[j] = a; sv[j] = b2;
              SB2(); }
          const float den = __shfl(wt_t * qc[2][0] + sv[2][0], fr);
          const float inv = __builtin_amdgcn_rcpf(fmaxf(fabsf(den), em_t));
#pragma unroll
          for (int j = 0; j < 2; ++j) { const int vb = 2 * half + j; float o[4];
#pragma unroll
              for (int i = 0; i < 4; ++i) o[i] = (wt_t * qc[j][i] + sv[j][i]) * inv;
              *(GAS v2u*)(hm + (size_t)(lrow0 + t0 + t) * 1024 + h * 256 + sl * 64 + 16 * vb + 4 * fq) = (v2u){pk2(o[0], o[1]), pk2(o[2], o[3])}; } }
        __syncthreads();
        if (c + 1 < L / 64) ML_LOAD_Q(t0 + 64);
        { bf16x8 kf[2][2], vf[5][2];
#pragma unroll
          for (int dbi = 0; dbi < 2; ++dbi)
#pragma unroll
            for (int ks = 0; ks < 2; ++ks) { const LAS unsigned char* p0 = lds + ML_KS + (32 * ks + 8 * fq + q4) * ML_P + (16 * (2 * w + dbi) + 4 * p4) * 2; kf[dbi][ks] = tr8(p0, p0 + 4 * ML_P); }
#pragma unroll
          for (int vb = 0; vb < 5; ++vb)
#pragma unroll
            for (int ks = 0; ks < 2; ++ks) { const LAS unsigned char* p0 = lds + ML_VW + (32 * ks + 8 * fq + q4) * ML_VP + (16 * vb + 4 * p4) * 2; vf[vb][ks] = tr8(p0, p0 + 4 * ML_VP); }
#pragma unroll
          for (int vb = 0; vb < 5; ++vb)
#pragma unroll
            for (int dbi = 0; dbi < 2; ++dbi) Cacc[vb][dbi] = Cacc[vb][dbi] * decay;
          SB3();
#pragma unroll
          for (int ks = 0; ks < 2; ++ks)
#pragma unroll
            for (int vb = 0; vb < 5; ++vb)
#pragma unroll
              for (int dbi = 0; dbi < 2; ++dbi) Cacc[vb][dbi] = MFMA16(kf[dbi][ks], vf[vb][ks], Cacc[vb][dbi]);
          SB3();
#pragma unroll
          for (int vb = 0; vb < 5; ++vb)
#pragma unroll
            for (int dbi = 0; dbi < 2; ++dbi) { const f32x4 a = Cacc[vb][dbi];
                *(LAS v2u*)(lds + ML_CT + (16 * vb + fr) * ML_P + (16 * (2 * w + dbi) + 4 * fq) * 2) = (v2u){pk2(a[0], a[1]), pk2(a[2], a[3])}; } }
        m_prev = g + M63;
        __syncthreads();
    }
#undef ML_LOAD_KV
#undef ML_LOAD_Q
}

constexpr int AT_KB = 0, AT_VB = 69632, AT_TBL = 139264, AT_KP = 272, AT_VP = 544, AT_KBUF = 17408, AT_VBUF = 34816, AT_XP = 1040;
DI void attn_item(Frame& F, int layer, int item) {
    const int qi = 31 - (item >> 4), r4 = item & 15, bl = r4 >> 2, h = r4 & 3;
    const int lrow0 = bl * L;
    const bf16* proj = (const bf16*)(F.ws + WS_PROJ); bf16* Y = (bf16*)(F.ws + WS_Y);
    LAS unsigned char* lds = F.lds; LAS float* tbl = (LAS float*)(lds + AT_TBL);
    const int tid = F.tid, lane = F.lane, w = F.wave, map = w >> 2, wq = w & 3, fr = lane & 15, fq = lane >> 4, q4 = fr >> 2, p4 = fr & 3;
    if (tid < 128) tbl[tid] = ((const float*)(F.ws + T_BIAS))[h * 128 + tid];
    else if (tid < 384) tbl[tid] = F.in[10][layer * 1024 + h * 256 + tid - 128];
    const float lam_full = ((const float*)(F.ws + T_LAM))[2 * layer], post = ((const float*)(F.ws + T_LAM))[2 * layer + 1];
    const int r0 = 64 * qi + 16 * wq;
    bf16x8 qf[4];
    { const bf16* qp = proj + (size_t)(lrow0 + r0 + fr) * NP + C_QD + h * 256 + map * 128 + 8 * fq;
#pragma unroll
      for (int ks = 0; ks < 4; ++ks) qf[ks] = *(const GAS bf16x8*)(qp + 32 * ks); }
    const bf16* kbase = proj + (size_t)lrow0 * NP + C_KD + h * 256;
    const bf16* vbase = proj + (size_t)lrow0 * NP + C_VD + h * 256;
    const int nkt = qi + 1;
    f32x4 O[16];
#pragma unroll
    for (int i = 0; i < 16; ++i) O[i] = (f32x4){0.f, 0.f, 0.f, 0.f};
    float mrun = -INFINITY, lsum = 0.f;
    const float sc2 = 0.08838834764831845f * 1.4426950408889634f;
    v4u kreg[4], vreg[4];
#define AT_LOAD(kt) do { _Pragma("unroll") for (int i = 0; i < 4; ++i) { const int q = tid + NTHR * i, row = q >> 5, c16 = q & 31; kreg[i] = *(const GAS v4u*)(kbase + (size_t)(64 * (kt) + row) * NP + 8 * c16); } \
        _Pragma("unroll") for (int i = 0; i < 4; ++i) { const int q = tid + NTHR * i, row = q >> 5, c16 = q & 31; vreg[i] = *(const GAS v4u*)(vbase + (size_t)(64 * (kt) + row) * NP + 8 * c16); } } while (0)
#define AT_STORE(buf) do { _Pragma("unroll") for (int i = 0; i < 4; ++i) { const int q = tid + NTHR * i, row = q >> 5, c16 = q & 31; *(LAS v4u*)(lds + AT_KB + ((c16 >> 4) * 2 + (buf)) * AT_KBUF + row * AT_KP + 16 * (c16 & 15)) = kreg[i]; } \
        _Pragma("unroll") for (int i = 0; i < 4; ++i) { const int q = tid + NTHR * i, row = q >> 5, c16 = q & 31; *(LAS v4u*)(lds + AT_VB + (buf) * AT_VBUF + row * AT_VP + 16 * c16) = vreg[i]; } } while (0)
    AT_LOAD(0); AT_STORE(0);
    __syncthreads();
    for (int kt = 0; kt < nkt; ++kt) {
        const int buf = kt & 1, k0 = 64 * kt;
        if (kt + 1 < nkt) AT_LOAD(kt + 1);
        {
            const LAS unsigned char* kb_ = lds + AT_KB + (map * 2 + buf) * AT_KBUF; const LAS unsigned char* vb_ = lds + AT_VB + buf * AT_VBUF;
            f32x4 s[4];
            { bf16x8 kf[16];
#pragma unroll
              for (int kb = 0; kb < 4; ++kb)
#pragma unroll
                for (int ks = 0; ks < 4; ++ks) kf[4 * kb + ks] = *(const LAS bf16x8*)(kb_ + (16 * kb + fr) * AT_KP + (32 * ks + 8 * fq) * 2);
              SB();
#pragma unroll
              for (int kb = 0; kb < 4; ++kb) s[kb] = (f32x4){0.f, 0.f, 0.f, 0.f};
#pragma unroll
              for (int ks = 0; ks < 4; ++ks)
#pragma unroll
                for (int kb = 0; kb < 4; ++kb) s[kb] = MFMA16(kf[4 * kb + ks], qf[ks], s[kb]);
              SB(); }
            const int qpos = r0 + fr; const bool far = (r0 - (k0 + 63)) >= 113; const float bfar = tbl[127];
            float mx = -INFINITY;
            if (far) {
#pragma unroll
                for (int kb = 0; kb < 4; ++kb)
#pragma unroll
                    for (int i = 0; i < 4; ++i) { const float v = s[kb][i] * sc2 + bfar; s[kb][i] = v; mx = fmaxf(mx, v); }
            } else {
#pragma unroll
                for (int kb = 0; kb < 4; ++kb)
#pragma unroll
                    for (int i = 0; i < 4; ++i) { const int kpos = k0 + 16 * kb + 4 * fq + i, dist = qpos - kpos;
                        const float bias = tbl[dist < 0 ? 0 : (dist > 127 ? 127 : dist)];
                        float v = s[kb][i] * sc2 + bias; if (dist < 0) v = -INFINITY; s[kb][i] = v; mx = fmaxf(mx, v); }
            }
            mx = fmaxf(mx, __shfl_xor(mx, 16)); mx = fmaxf(mx, __shfl_xor(mx, 32));
            const float mnew = fmaxf(mrun, mx), alpha = ex2(mrun - mnew);
            const bool grow = __any(mnew > mrun);
            mrun = mnew;
            float ps = 0.f;
#pragma unroll
            for (int kb = 0; kb < 4; ++kb)
#pragma unroll
                for (int i = 0; i < 4; ++i) { const float p = ex2(s[kb][i] - mnew); s[kb][i] = p; ps += p; }
            lsum = lsum * alpha + ps;
            if (grow) {
#pragma unroll
                for (int i = 0; i < 16; ++i) O[i] = O[i] * alpha;
            }
            bf16x8 pb[2];
#pragma unroll
            for (int k2 = 0; k2 < 2; ++k2) { v4u t; t.x = pk2(s[2 * k2][0], s[2 * k2][1]); t.y = pk2(s[2 * k2][2], s[2 * k2][3]); t.z = pk2(s[2 * k2 + 1][0], s[2 * k2 + 1][1]); t.w = pk2(s[2 * k2 + 1][2], s[2 * k2 + 1][3]);
                pb[k2] = __builtin_bit_cast(bf16x8, t); }
            bf16x8 vfa[8], vfb[8];
#define AT_VLOAD(dst, b) do { _Pragma("unroll") for (int j = 0; j < 4; ++j) _Pragma("unroll") for (int k2 = 0; k2 < 2; ++k2) { \
                const LAS unsigned char* p0 = vb_ + (32 * k2 + 4 * fq + q4) * AT_VP + (16 * (4 * (b) + j) + 4 * p4) * 2; dst[2 * j + k2] = tr8(p0, p0 + 16 * AT_VP); } } while (0)
#define AT_VMMA(src, b) do { _Pragma("unroll") for (int j = 0; j < 4; ++j) _Pragma("unroll") for (int k2 = 0; k2 < 2; ++k2) O[4 * (b) + j] = MFMA16(src[2 * j + k2], pb[k2], O[4 * (b) + j]); } while (0)
            AT_VLOAD(vfa, 0); SB();
            AT_VLOAD(vfb, 1); SB(); AT_VMMA(vfa, 0); SB();
            AT_VLOAD(vfa, 2); SB(); AT_VMMA(vfb, 1); SB();
            AT_VLOAD(vfb, 3); SB(); AT_VMMA(vfa, 2); SB();
            AT_VMMA(vfb, 3); SB();
#undef AT_VLOAD
#undef AT_VMMA
        }
        if (kt + 1 < nkt) AT_STORE(buf ^ 1);
        __syncthreads();
    }
#undef AT_LOAD
#undef AT_STORE
    lsum += __shfl_xor(lsum, 16); lsum += __shfl_xor(lsum, 32);
    const float inv = 1.0f / lsum;
    LAS unsigned char* xo = lds + (16 * wq + fr) * AT_XP + 16 * fq;
    if (map == 1) {
#pragma unroll
        for (int vb = 0; vb < 16; ++vb) *(LAS f32x4*)(xo + 64 * vb) = O[vb] * inv; }
    __syncthreads();
    if (map == 0) {
        float ss = 0.f;
#pragma unroll
        for (int vb = 0; vb < 16; ++vb) { const f32x4 o2 = *(const LAS f32x4*)(xo + 64 * vb); const f32x4 d = O[vb] * inv - o2 * lam_full; O[vb] = d;
            ss += (d.x * d.x + d.y * d.y) + (d.z * d.z + d.w * d.w); }
        ss += __shfl_xor(ss, 16); ss += __shfl_xor(ss, 32);
        const float rstd = post / sqrtf(ss * (1.0f / 256.0f) + EPS);
        const LAS float* gdn = tbl + 128 + 4 * fq;
        bf16* yp = Y + (size_t)MC * 1024 + (size_t)(lrow0 + r0 + fr) * 1024 + h * 256 + 4 * fq;
#pragma unroll
        for (int vb = 0; vb < 16; ++vb) { const f32x4 g = *(const LAS f32x4*)(gdn + 16 * vb); const f32x4 o = O[vb] * rstd * g;
            *(GAS v2u*)(yp + 16 * vb) = (v2u){pk2(o.x, o.y), pk2(o.z, o.w)}; }
    }
}

constexpr int S5_WB = 12800, S5_BUP = 528, S5_XO = 8448, S5_XP = 272;
DI void s5_item(Frame& F, int layer, int item) {
    const int bl = item >> 3, g = (item & 7) * 8 + F.wave, lrow0 = bl * L;
    const bf16* proj = (const bf16*)(F.ws + WS_PROJ); bf16* ys5 = (bf16*)(F.ws + WS_YS5);
    LAS unsigned char* bu = F.lds + F.wave * S5_WB; LAS unsigned char* xs = bu + S5_XO;
    const int lane = F.lane, fr = lane & 15, fq = lane >> 4;
    const int lg = layer * 64 + g;
    bf16x8 bbf[8], ctf[4];
    const bf16x8 zf = (bf16x8){0, 0, 0, 0, 0, 0, 0, 0};
#pragma unroll
    for (int nb = 0; nb < 8; ++nb) { bbf[nb] = zf; if (fq < 2) bbf[nb] = *(const GAS bf16x8*)((const bf16*)(F.ws + T_BBT) + ((size_t)lg * 128 + 16 * nb + fr) * 16 + 8 * fq); }
#pragma unroll
    for (int ks = 0; ks < 4; ++ks) ctf[ks] = *(const GAS bf16x8*)((const bf16*)(F.ws + T_CT) + ((size_t)lg * 16 + fr) * 128 + 32 * ks + 8 * fq);
    const float ar = ((const float*)(F.ws + T_S5A))[2 * (lg * 64 + lane)], ai = ((const float*)(F.ws + T_S5A))[2 * (lg * 64 + lane) + 1];
    const float dsk = F.in[19][layer * 1024 + g * 16 + fr];
    bf16x8 dskf = zf;
#pragma unroll
    for (int j = 0; j < 8; ++j) if (fq < 2 && 8 * fq + j == fr) dskf[j] = (short)f2bf(dsk);
    float xr = 0.f, xi = 0.f;
    const bf16* up = proj + (size_t)lrow0 * NP + C_US + g * 16;
    bf16x8 ac[4], an[4];
#pragma unroll
    for (int k = 0; k < 4; ++k) { ac[k] = zf; an[k] = zf; if (fq < 2) ac[k] = *(const GAS bf16x8*)(up + (size_t)(16 * k + fr) * NP + 8 * fq); }
    for (int blk = 0; blk < L / 64; ++blk) {
        if (blk + 1 < L / 64) {
#pragma unroll
            for (int k = 0; k < 4; ++k) if (fq < 2) an[k] = *(const GAS bf16x8*)(up + (size_t)(64 * (blk + 1) + 16 * k + fr) * NP + 8 * fq); }
#pragma unroll
        for (int k = 0; k < 4; ++k) {
            const int t0 = 64 * blk + 16 * k; const bf16x8 a = ac[k];
#pragma unroll
            for (int nb = 0; nb < 8; ++nb) { const f32x4 acc = MFMA16(bbf[nb], a, ((f32x4){0.f, 0.f, 0.f, 0.f}));
                *(LAS f32x4*)(bu + fr * S5_BUP + 4 * (16 * nb + 4 * fq)) = acc; }
            LDS_WAIT();
            f32x2 b2[16];
#pragma unroll
            for (int t = 0; t < 16; ++t) b2[t] = *(const LAS f32x2*)(bu + t * S5_BUP + 8 * lane);
#pragma unroll
            for (int t = 0; t < 16; ++t) { const float nr = ar * xr - ai * xi + b2[t].x, ni = ar * xi + ai * xr + b2[t].y; xr = nr; xi = ni;
                *(LAS unsigned*)(xs + t * S5_XP + 4 * lane) = pk2(xr, xi); }
            LDS_WAIT();
            bf16x8 xa[4];
#pragma unroll
            for (int ks = 0; ks < 4; ++ks) xa[ks] = *(const LAS bf16x8*)(xs + fr * S5_XP + (32 * ks + 8 * fq) * 2);
            f32x4 y = MFMA16(dskf, a, ((f32x4){0.f, 0.f, 0.f, 0.f}));
#pragma unroll
            for (int ks = 0; ks < 4; ++ks) y = MFMA16(ctf[ks], xa[ks], y);
            *(GAS v2u*)(ys5 + (size_t)(lrow0 + t0 + fr) * 1024 + g * 16 + 4 * fq) = (v2u){pk2(gelu_tanh(y[0]), gelu_tanh(y[1])), pk2(gelu_tanh(y[2]), gelu_tanh(y[3]))};
            LDS_WAIT();
        }
#pragma unroll
        for (int k = 0; k < 4; ++k) ac[k] = an[k];
    }
}

DI void p4_post_norms(Frame& F, int layer) {
    const bf16* proj = (const bf16*)(F.ws + WS_PROJ); const bf16* hm = (const bf16*)(F.ws + WS_HM);
    bf16* Y = (bf16*)(F.ws + WS_Y);
    const int lane = F.lane;
    const float* gm = F.in[8] + layer * 1024;
    const int gw = F.bid * NWAVES + F.wave, NGW = F.G * NWAVES;
    for (int r = gw; r < MC; r += NGW) {
#pragma unroll
        for (int h = 0; h < 4; ++h) { const int c = h * 256 + 4 * lane;
            const v2u hv = *(const GAS v2u*)(hm + (size_t)r * 1024 + c), ov = *(const GAS v2u*)(proj + (size_t)r * NP + C_OM + c);
            const float v0 = bflo(hv.x), v1 = bfhi(hv.x), v2 = bflo(hv.y), v3 = bfhi(hv.y);
            const float rstd = 1.0f / sqrtf(wave_sum(v0 * v0 + v1 * v1 + v2 * v2 + v3 * v3) * (1.0f / 256.0f) + EPS);
            const f32x4 gg = *(const GAS f32x4*)(gm + c);
            v2u o; o.x = pk2(sigm(bflo(ov.x)) * v0 * rstd * gg.x, sigm(bfhi(ov.x)) * v1 * rstd * gg.y); o.y = pk2(sigm(bflo(ov.y)) * v2 * rstd * gg.z, sigm(bfhi(ov.y)) * v3 * rstd * gg.w);
            *(GAS v2u*)(Y + (size_t)r * 1024 + c) = o; }
    }
}

#ifndef RES_NO_NT
#define PR_ST(p_, v_) __builtin_nontemporal_store((v_), (p_))
#else
#define PR_ST(p_, v_) (*(p_) = (v_))
#endif
#ifndef RES_NO_NT_LD
#define PR_LD(p_) __builtin_nontemporal_load(p_)
#else
#define PR_LD(p_) (*(p_))
#endif
template <bool XIN_F32, bool XOUT_F32, int XN_I8 = 0>
DI void p_residual(Frame& F, int nrows, const bf16* ysrc, const void* xsrc_, void* out_, bf16* xn, const float* gpost, const float* gnext, float* sa = nullptr, unsigned char* xn8 = nullptr) {
    const int lane = F.lane, gw = F.bid * NWAVES + F.wave, NGW = F.G * NWAVES;
    const float* xsrc32 = (const float*)xsrc_; const bf16* xsrc16 = (const bf16*)xsrc_; float* out32 = (float*)out_; bf16* out16 = (bf16*)out_;
    f32x4 gp[8], gn[8];
#pragma unroll
    for (int j = 0; j < 8; ++j) { const int c = 4 * (lane + 64 * j); gp[j] = *(const GAS f32x4*)(gpost + c); gn[j] = gnext ? *(const GAS f32x4*)(gnext + c) : (f32x4){0.f, 0.f, 0.f, 0.f}; }
    constexpr bool DEEP = !XIN_F32;
    v2u yw[8], ywn[8], ywn2[DEEP ? 8 : 1]; f32x4 xv[XIN_F32 ? 8 : 1], xvn[XIN_F32 ? 8 : 1]; v2u xw[XIN_F32 ? 1 : 8], xwn[XIN_F32 ? 1 : 8], xwn2[XIN_F32 ? 1 : 8];
#define PR_LOAD(r_, YW, XV, XW) do { _Pragma("unroll") for (int j = 0; j < 8; ++j) { YW[j] = PR_LD((const GAS v2u*)(ysrc + (size_t)(r_) * D + 4 * (lane + 64 * j))); \
        if constexpr (XIN_F32) XV[j] = PR_LD((const GAS f32x4*)(xsrc32 + (size_t)(r_) * D + 4 * (lane + 64 * j))); \
        else XW[j] = PR_LD((const GAS v2u*)(xsrc16 + (size_t)(r_) * D + 4 * (lane + 64 * j))); } } while (0)
    if (gw < nrows) PR_LOAD(gw, yw, xv, xw);
    if constexpr (DEEP) { if (gw + NGW < nrows) PR_LOAD(gw + NGW, ywn, xvn, xwn); }
    for (int r = gw; r < nrows; r += NGW) { const size_t grow = (size_t)r;
        if constexpr (DEEP) { if (r + 2 * NGW < nrows) PR_LOAD(r + 2 * NGW, ywn2, xvn, xwn2); }
        else { if (r + NGW < nrows) PR_LOAD(r + NGW, ywn, xvn, xwn); }
        f32x4 y[8]; float s = 0.f;
#pragma unroll
        for (int j = 0; j < 8; ++j) { y[j] = (f32x4){bflo(yw[j].x), bfhi(yw[j].x), bflo(yw[j].y), bfhi(yw[j].y)}; s += (y[j].x * y[j].x + y[j].y * y[j].y) + (y[j].z * y[j].z + y[j].w * y[j].w); }
        const float rstd = 1.0f / sqrtf(wave_sum(s) * (1.0f / D) + EPS);
        float s2 = 0.f;
#pragma unroll
        for (int j = 0; j < 8; ++j) { f32x4 xin; if constexpr (XIN_F32) xin = xv[j]; else xin = (f32x4){bflo(xw[j].x), bfhi(xw[j].x), bflo(xw[j].y), bfhi(xw[j].y)};
            const f32x4 o = xin + y[j] * rstd * gp[j];
            if (XOUT_F32) PR_ST((GAS f32x4*)(out32 + grow * D + 4 * (lane + 64 * j)), o);
            else PR_ST((GAS v2u*)(out16 + grow * D + 4 * (lane + 64 * j)), ((v2u){pk2(o.x, o.y), pk2(o.z, o.w)}));
            y[j] = o;
            s2 += (o.x * o.x + o.y * o.y) + (o.z * o.z + o.w * o.w); }
        if (gnext) { const float rstd2 = 1.0f / sqrtf(wave_sum(s2) * (1.0f / D) + EPS);
#pragma unroll
            for (int j = 0; j < 8; ++j) y[j] = y[j] * rstd2 * gn[j];
            if (XN_I8) { float mx = 0.f; unsigned char* o8 = XN_I8 == 2 ? xn8 : (unsigned char*)xn;
#pragma unroll
                for (int j = 0; j < 8; ++j) mx = fmaxf(fmaxf(mx, fmaxf(fabsf(y[j].x), fabsf(y[j].y))), fmaxf(fabsf(y[j].z), fabsf(y[j].w)));
                mx = wave_max(mx); const float inv = mx > 0.f ? 127.0f / mx : 0.f;
#pragma unroll
                for (int j = 0; j < 8; ++j) PR_ST((GAS unsigned*)(o8 + grow * D + 4 * (lane + 64 * j)), pack_i8(y[j], inv));
                if (lane == 0) sa[grow] = mx * (1.0f / 127.0f);
            }
            if (XN_I8 != 1) {
#pragma unroll
                for (int j = 0; j < 8; ++j) { const f32x4 o = y[j];
                    PR_ST((GAS v2u*)(xn + grow * D + 4 * (lane + 64 * j)), ((v2u){pk2(o.x, o.y), pk2(o.z, o.w)})); } } }
#pragma unroll
        for (int j = 0; j < 8; ++j) { yw[j] = ywn[j]; if constexpr (XIN_F32) xv[j] = xvn[j]; else { xw[j] = xwn[j]; xwn[j] = xwn2[j]; ywn[j] = ywn2[j]; } }
    }
#undef PR_LOAD
}

DI void p9_fixup(Frame& F, int layer) {
    const bf16* raw = (const bf16*)(F.ws + WS_RAW); bf16* act = (bf16*)(F.ws + WS_ACT);

    const float* cw = F.in[24] + (size_t)layer * 3 * NUP; const float* cb = F.in[25] + (size_t)layer * NUP;
    const int gt = F.bid * NTHR + F.tid, NGT = F.G * NTHR;
    constexpr int NCG = DFF / 8;
    for (int task = gt; task < NCG * (MH / 64); task += NGT) {
        const int cg = task % NCG, blk = task / NCG, c = 8 * cg, t0 = (blk * 64) & (L - 1);
        const bf16* rb = raw + (size_t)blk * 4 * 2 * DFF + c;
        const bf16* rp = rb - (size_t)4 * 2 * DFF;
        v4u xa[4], xv[4];
#pragma unroll
        for (int k = 0; k < 2; ++k) { xa[k] = (v4u){0u, 0u, 0u, 0u}; xv[k] = xa[k];
            if (t0 > 0) { xa[k] = *(const GAS v4u*)(rp + (size_t)(2 + k) * 2 * DFF); xv[k] = *(const GAS v4u*)(rp + (size_t)(2 + k) * 2 * DFF + DFF); }
            xa[2 + k] = *(const GAS v4u*)(rb + (size_t)k * 2 * DFF); xv[2 + k] = *(const GAS v4u*)(rb + (size_t)k * 2 * DFF + DFF); }
#pragma unroll
        for (int r = 0; r < 2; ++r) {
            unsigned o[4];
#pragma unroll
            for (int k = 0; k < 4; ++k) { float res[2];
#pragma unroll
                for (int hh = 0; hh < 2; ++hh) { const int cc = c + 2 * k + hh;
                    const float a0 = hh ? bfhi(xa[r][k]) : bflo(xa[r][k]), a1 = hh ? bfhi(xa[r + 1][k]) : bflo(xa[r + 1][k]), a2 = hh ? bfhi(xa[r + 2][k]) : bflo(xa[r + 2][k]);
                    const float v0 = hh ? bfhi(xv[r][k]) : bflo(xv[r][k]), v1 = hh ? bfhi(xv[r + 1][k]) : bflo(xv[r + 1][k]), v2 = hh ? bfhi(xv[r + 2][k]) : bflo(xv[r + 2][k]);
                    const float ya = cw[cc] * a0 + cw[NUP + cc] * a1 + cw[2 * NUP + cc] * a2 + cb[cc];
                    const float yv = cw[DFF + cc] * v0 + cw[NUP + DFF + cc] * v1 + cw[2 * NUP + DFF + cc] * v2 + cb[DFF + cc];
                    res[hh] = gelu_tanh(ya) * yv; }
                o[k] = pk2(res[0], res[1]); }
            *(GAS v4u*)(act + (size_t)(blk * 64 + r) * DFF + c) = (v4u){o[0], o[1], o[2], o[3]};
        }
    }
}
#define XB_TMO      128
#define XB_XCNT(j)  (256  + 64 * (j))
#define XB_XSUB(j)  (1280 + 64 * (j))
#define XB_XGEN(j)  (2304 + 64 * (j))
#define XB_TOP      3328
#define XB_TOPGEN   3392
#define XCD_BAR_WORDS 3456
#define XB_SPIN_CAP (1u << 18)

__device__ __forceinline__ unsigned xb_ld(unsigned* p)              { return __hip_atomic_load(p, __ATOMIC_RELAXED, __HIP_MEMORY_SCOPE_AGENT); }
__device__ __forceinline__ unsigned xb_add(unsigned* p, unsigned v) { return __hip_atomic_fetch_add(p, v, __ATOMIC_RELAXED, __HIP_MEMORY_SCOPE_AGENT); }
__device__ __forceinline__ unsigned xb_xcc_id() { return (unsigned)__builtin_amdgcn_s_getreg((3 << 11) | 20) & 0xFu; }
#define XB_SPIN(cond, bar) do { unsigned _sp = 0; while (cond) { __builtin_amdgcn_s_sleep(1); \
    if ((++_sp & 255u) == 0u) { if (xb_ld(&(bar)[XB_TMO])) break; if (_sp > XB_SPIN_CAP) { atomicAdd(&(bar)[XB_TMO], 1u); break; } } } } while (0)

struct XcdBarrier {
    unsigned* bar; unsigned x;
    volatile LAS unsigned* st;
};

__device__ __forceinline__ XcdBarrier xcd_barrier_post(unsigned* bar, volatile LAS unsigned* st) {
    XcdBarrier b; b.bar = bar; b.x = xb_xcc_id(); b.st = st;
    if (threadIdx.x == 0) (void)xb_add(&bar[XB_XCNT(b.x)], 1u);
    return b;
}
__device__ __forceinline__ void xcd_barrier_complete(unsigned* bar, unsigned x, unsigned& nloc, unsigned& nx) {
    const unsigned G = gridDim.x * gridDim.y * gridDim.z;
    unsigned sum, cnt, mine, sp = 0u;
    for (;;) {
        sum = 0u; cnt = 0u; mine = 0u;
#pragma unroll
        for (unsigned j = 0; j < 16; ++j) { const unsigned c = xb_ld(&bar[XB_XCNT(j)]); sum += c; cnt += (c > 0u) ? 1u : 0u; mine = (j == x) ? c : mine; }
        if (sum == G) break;
        __builtin_amdgcn_s_sleep(1);
        if ((++sp & 255u) == 0u) { if (xb_ld(&bar[XB_TMO])) break; if (sp > XB_SPIN_CAP) { atomicAdd(&bar[XB_TMO], 1u); break; } }
    }
    nloc = mine > 0u ? mine : 1u; nx = cnt > 0u ? cnt : 1u;
}

__device__ __forceinline__ void xcd_barrier(const XcdBarrier& b) {
    asm volatile("s_waitcnt vmcnt(0)" ::: "memory");
    __syncthreads();
    if (threadIdx.x == 0) {
        unsigned* bar = b.bar;
        __builtin_amdgcn_s_waitcnt(0);
        unsigned nloc = b.st[0], nx = b.st[1];
        if (nloc == 0u) { xcd_barrier_complete(bar, b.x, nloc, nx); b.st[0] = nloc; b.st[1] = nx; }
        const unsigned old = xb_add(&bar[XB_XSUB(b.x)], 1u);
        const unsigned gen = old / nloc;
        if (old + 1u == (gen + 1u) * nloc) {
            __builtin_amdgcn_fence(__ATOMIC_RELEASE, "agent");
            asm volatile("s_waitcnt vmcnt(0)" ::: "memory");
            const unsigned og = xb_add(&bar[XB_TOP], 1u);
            const unsigned tg = og / nx;
            if (og + 1u == (tg + 1u) * nx) xb_add(&bar[XB_TOPGEN], 1u);
            else XB_SPIN(xb_ld(&bar[XB_TOPGEN]) == tg, bar);
            __builtin_amdgcn_fence(__ATOMIC_ACQUIRE, "agent");
            xb_add(&bar[XB_XGEN(b.x)], 1u);
            asm volatile("s_waitcnt vmcnt(0)" ::: "memory");
        } else {
            XB_SPIN(xb_ld(&bar[XB_XGEN(b.x)]) == gen, bar);
            __builtin_amdgcn_fence(__ATOMIC_ACQUIRE, "agent");
            asm volatile("s_waitcnt vmcnt(0)" ::: "memory");
        }
    }
    __syncthreads();
}

struct Args { const float* in[27]; float* out; unsigned char* ws; int lc_lo, lc_hi, ph_lo, ph_hi, use_bar, pad; };
constexpr int N_ITEMS_ML = 64, N_ITEMS_S5 = 32, N_ITEMS_AT = 512, N_ITEMS = N_ITEMS_ML + N_ITEMS_S5 + N_ITEMS_AT;

__global__ void __launch_bounds__(NTHR, 2) fwd_kernel(Args args) {
    extern __shared__ __attribute__((aligned(16))) unsigned char lds_raw[];
    Frame F;
    F.lds = (LAS unsigned char*)lds_raw;
    F.MISC = (volatile LAS unsigned*)(F.lds + LDSCTL_OFF);
    F.tid = threadIdx.x; F.lane = F.tid & 63; F.wave = __builtin_amdgcn_readfirstlane(F.tid >> 6);
    F.G = gridDim.x; F.bid = blockIdx.x;
    F.ws = args.ws; F.ctl = (gu32*)(args.ws + WS_CTL); F.out = args.out;
    F.in = args.in;
    for (int u = F.tid; u < (LDS_BYTES - LDSCTL_OFF) / 4; u += NTHR) ((LAS unsigned*)(F.lds + LDSCTL_OFF))[u] = 0u;
    __syncthreads();
    XcdBarrier bar; bar.bar = (unsigned*)(F.ctl + CW_BAR); bar.x = 0; bar.st = nullptr;
    if (args.use_bar) bar = xcd_barrier_post((unsigned*)(F.ctl + CW_BAR), F.MISC + 8);
#ifdef DBG_DOUBLE_BAR
#define GRID_BAR() do { if (args.use_bar) { xcd_barrier(bar); xcd_barrier(bar); } } while (0)
#else
#define GRID_BAR() do { if (args.use_bar) { unsigned* b_ = (unsigned*)(args.ws + WS_CTL) + CW_BAR; asm volatile("" : "+s"(b_)); bar.bar = b_; xcd_barrier(bar); } } while (0)
#endif
    const int lo = args.ph_lo, hi = args.ph_hi;
#ifndef PH_MASK
#define PH_MASK 0xFFF
#endif
#ifndef GEMM_ALIGN
#define GEMM_ALIGN true
#endif
#ifndef GEMM_SP2
#define GEMM_SP2 true
#endif
#ifndef DBG_REPEAT
#define DBG_REPEAT -1
#endif
#ifndef DBG_STORE_MOD
#define DBG_STORE_MOD 1000000
#endif
#define REP(k) ((k) == DBG_REPEAT ? 2 : 1)
#define IN(k) (((PH_MASK >> (k)) & 1) && lo <= (k) && (k) < hi)
#define RELAUNDER() do { int t_ = threadIdx.x; asm volatile("" : "+v"(t_)); F.tid = t_; F.lane = t_ & 63; F.wave = __builtin_amdgcn_readfirstlane(t_ >> 6); \
        unsigned char* w_ = args.ws; asm volatile("" : "+s"(w_)); F.ws = w_; F.ctl = (gu32*)(w_ + WS_CTL); float* o_ = args.out; asm volatile("" : "+s"(o_)); F.out = o_; } while (0)

    for (int layer = 0; layer < DEPTH; ++layer) {
        for (int rep = 0; rep < REP(0); ++rep) if (IN(0)) { RELAUNDER(); p0_weights(F, layer); if (layer == 0) p0_tables(F); __syncthreads(); GRID_BAR(); }

        for (int chunk = 0; chunk < NCH; ++chunk) {
            const int lc = layer * NCH + chunk;
            for (int rep = 0; rep < REP(1); ++rep) if (IN(1)) { RELAUNDER();
                { pg8::Gemm g{(const bf16*)(F.ws + WS_XN) + (size_t)chunk * MC * D, (const bf16*)(F.ws + WS_WIN), MC, 4096, D, nullptr};
                  pg8::StaticOrder S; S.init(MC, 4096, F.G, F.bid);
                  pg8::EpiBf16 E{(bf16*)(F.ws + WS_PROJ), NP, 0, 1 << 30, 8, 2048};
                  pg8::gemm_phase<pg8::EpiBf16, pg8::StaticOrder, GEMM_ALIGN, GEMM_SP2>(F.lds, g, S, E); }
                RELAUNDER();
                { pg8::Gemm g{(const bf16*)(F.ws + WS_XN8M + (size_t)chunk * MC * D), (const bf16*)(F.ws + WS_WG8), MC, NI8, D, nullptr};
                  pg8::StaticOrder S; S.init(MC, NI8, F.G, F.bid);
                  pg8::EpiGateI8 E{(bf16*)(F.ws + WS_PROJ), NP, C_GATE, (const float*)(F.ws + T_SA_MIX) + (size_t)chunk * MC, (const float*)(F.ws + T_SB_G)};
                  pg8::gemm_phase<pg8::EpiGateI8, pg8::StaticOrder, GEMM_ALIGN, GEMM_SP2, true>(F.lds, g, S, E); }
                GRID_BAR();
            }
            for (int rep = 0; rep < REP(2); ++rep) if (IN(2)) { RELAUNDER(); p2_conv_gates(F, layer, chunk); GRID_BAR(); }

            for (int rep3 = 0; rep3 < REP(3); ++rep3) if (IN(3)) {
                for (;;) { RELAUNDER();
                    const int xq = F.bid & 7;
                    if (F.tid == 0) F.MISC[0] = __hip_atomic_fetch_add(F.ctl + CW_QUEUE + 64 * (lc + 8 * rep3) + 8 * xq, 1u, RLX_AGENT);
                    __syncthreads();
                    const int qpos = __builtin_amdgcn_readfirstlane((int)F.MISC[0]);
                    __syncthreads();
                    if (qpos >= N_ITEMS / 8) break;
                    int item;
                    if (qpos < N_ITEMS_ML / 8) item = (N_ITEMS_ML / 8) * xq + qpos;
                    else if (qpos < (N_ITEMS_ML + N_ITEMS_S5) / 8) item = N_ITEMS_ML + (N_ITEMS_S5 / 8) * xq + (qpos - N_ITEMS_ML / 8);
                    else { const int a = qpos - (N_ITEMS_ML + N_ITEMS_S5) / 8; item = N_ITEMS_ML + N_ITEMS_S5 + ((a >> 1) << 4) + 2 * xq + (a & 1); }
#ifndef IT_MASK
#define IT_MASK 7
#endif
#ifndef DBG_REP_ITEMS
#define DBG_REP_ITEMS 7
#endif
                    const int itm = rep3 ? (IT_MASK & DBG_REP_ITEMS) : IT_MASK;
                    if (item < N_ITEMS_ML) { if (itm & 1) mlstm_item(F, chunk, item); }
                    else if (item < N_ITEMS_ML + N_ITEMS_S5) { if (itm & 2) s5_item(F, layer, item - N_ITEMS_ML); }
                    else { if (itm & 4) attn_item(F, layer, item - N_ITEMS_ML - N_ITEMS_S5); }
                    __syncthreads();
                }
                GRID_BAR();
            }
            for (int rep = 0; rep < REP(4); ++rep) if (IN(4)) { RELAUNDER();
                pg8::Gemm g{(const bf16*)(F.ws + WS_YS5), (const bf16*)(F.ws + WS_WGLU), MC, 2048, 1024, nullptr};
                pg8::StaticOrder S; S.init(MC, 2048, F.G, F.bid);
                pg8::EpiGlu E{(bf16*)(F.ws + WS_Y) + (size_t)2 * MC * 1024, 1024};
                pg8::gemm_phase<pg8::EpiGlu, pg8::StaticOrder, true, GEMM_SP2>(F.lds, g, S, E);
                p4_post_norms(F, layer);
                GRID_BAR();
            }
            for (int rep = 0; rep < REP(5); ++rep) if (IN(5)) { RELAUNDER();
                pg8::Gemm g{(const bf16*)(F.ws + WS_Y), (const bf16*)(F.ws + WS_WB), 3 * MC, 3 * 2048, 1024, nullptr};
                pg8::BranchOrder S; S.init(F.G, F.bid);
                pg8::EpiBranch E{(const bf16*)(F.ws + WS_PROJ), NP, C_GATE, (bf16*)(F.ws + WS_MERGED) + (size_t)chunk * MC * D, (const bf16*)(F.ws + T_ONES)};
                pg8::gemm_phase<pg8::EpiBranch, pg8::BranchOrder, true, GEMM_SP2>(F.lds, g, S, E);
                GRID_BAR();
            }
        }
        for (int rep = 0; rep < REP(6); ++rep) if (IN(6)) { RELAUNDER();
            pg8::Gemm g{(const bf16*)(F.ws + WS_MERGED), (const bf16*)(F.ws + WS_WOUT), M, D, D, nullptr};
            pg8::StaticOrder S; S.init(M, D, F.G, F.bid);
            pg8::EpiBf16 E{(bf16*)(F.ws + WS_MIX), D, 0, 1 << 30, 1 << 30, 0};
            pg8::gemm_phase<pg8::EpiBf16, pg8::StaticOrder, GEMM_ALIGN, GEMM_SP2>(F.lds, g, S, E);
            GRID_BAR();
        }
        for (int rep = 0; rep < (layer == 0 ? REP(7) : 1); ++rep) if (IN(7)) { RELAUNDER();
            if (layer == 0) p_residual<true, false, 1>(F, M, (const bf16*)(F.ws + WS_MIX), F.in[0], F.ws + WS_XB, (bf16*)(F.ws + WS_XN8F), F.in[2] + layer * D, F.in[3] + layer * D, (float*)(F.ws + T_SA_FFN));
            else p_residual<false, false, 1>(F, M, (const bf16*)(F.ws + WS_MIX), F.ws + WS_XB, F.ws + WS_XB, (bf16*)(F.ws + WS_XN8F), F.in[2] + layer * D, F.in[3] + layer * D, (float*)(F.ws + T_SA_FFN));
            GRID_BAR();
        }
        for (int half = 0; half < M / MH; ++half) {
            for (int rep = 0; rep < REP(8); ++rep) if (IN(8)) { RELAUNDER();
                pg8::Gemm g{(const bf16*)(F.ws + WS_XN8F + (size_t)half * MH * D), (const bf16*)(F.ws + WS_WUP), MH, NUP, D, nullptr};
                pg8::GemmOrder S; S.init(MH, NUP, F.G, F.bid, D / 64);
                pg8::EpiUpConv<true> E{(bf16*)(F.ws + WS_ACT), (bf16*)(F.ws + WS_RAW), F.in[24] + (size_t)layer * 3 * NUP, F.in[25] + (size_t)layer * NUP, DFF, NUP, (const float*)(F.ws + T_SA_FFN) + (size_t)half * MH, (const float*)(F.ws + T_SB_UP)
                };
                pg8::gemm_phase<pg8::EpiUpConv<true>, pg8::GemmOrder, GEMM_ALIGN, GEMM_SP2, true>(F.lds, g, S, E);
                GRID_BAR();
            }
            for (int rep = 0; rep < REP(9); ++rep) if (IN(9)) { RELAUNDER(); p9_fixup(F, layer); GRID_BAR(); }
            for (int rep = 0; rep < REP(10); ++rep) if (IN(10)) { RELAUNDER();
                pg8::Gemm g{(const bf16*)(F.ws + WS_ACT), (const bf16*)(F.ws + WS_WDN), MH, D, DFF, nullptr};
                pg8::StaticOrder S; S.init(MH, D, F.G, F.bid);
                pg8::EpiBf16 E{(bf16*)(F.ws + WS_FFN), D, 0, 1 << 30, 1 << 30, 0};
                pg8::gemm_phase<pg8::EpiBf16, pg8::StaticOrder, GEMM_ALIGN, GEMM_SP2>(F.lds, g, S, E);
                GRID_BAR();
            }
            if (IN(11)) { RELAUNDER();
                const size_t ro = (size_t)half * MH * D;
                if (layer + 1 < DEPTH) p_residual<false, false, 2>(F, MH, (const bf16*)(F.ws + WS_FFN), (const bf16*)(F.ws + WS_XB) + ro, (bf16*)(F.ws + WS_XB) + ro, (bf16*)(F.ws + WS_XN) + ro, F.in[4] + layer * D, F.in[1] + (layer + 1) * D,
                                                                      (float*)(F.ws + T_SA_MIX) + (size_t)half * MH, F.ws + WS_XN8M + ro);
                else p_residual<false, true>(F, MH, (const bf16*)(F.ws + WS_FFN), (const bf16*)(F.ws + WS_XB) + ro, F.out + ro, nullptr, F.in[4] + layer * D, nullptr);
                GRID_BAR();
            }
        }
    }
#undef IN
#undef GRID_BAR
}


#ifdef DBG_DUMP
__global__ void dbg_dump(const unsigned char* ws, float* out, size_t off, size_t nelem, int is_f32) {
    for (size_t i = (size_t)blockIdx.x * blockDim.x + threadIdx.x; i < (size_t)M * D; i += (size_t)gridDim.x * blockDim.x) {
        const size_t j = i % nelem; out[i] = is_f32 ? ((const float*)(ws + off))[j] : __uint_as_float(((unsigned)((const unsigned short*)(ws + off))[j]) << 16); }
}
#endif

#ifndef MK_SINGLE
#define MK_SINGLE 1
#endif
extern "C" void kernel_launch(void* const* d_in, const int* in_sizes, int n_in, void* d_out, int out_size, void* d_ws, size_t ws_size, hipStream_t stream) {
    static int grid = 0;
    if (grid == 0) {
        if (n_in != 27 || in_sizes[0] != M * D || out_size != M * D || ws_size < WS_END) { fprintf(stderr, "kernel_launch: unexpected shapes (n_in %d, in0 %d, out %d, ws %zu)\n", n_in, n_in > 0 ? in_sizes[0] : -1, out_size, ws_size); grid = -1; return; }
        int dev = 0, cus = 0, per_cu = 0;
        if (hipGetDevice(&dev) != hipSuccess || hipDeviceGetAttribute(&cus, hipDeviceAttributeMultiprocessorCount, dev) != hipSuccess) { grid = -1; return; }
        if (hipFuncSetAttribute((const void*)fwd_kernel, hipFuncAttributeMaxDynamicSharedMemorySize, LDS_BYTES) != hipSuccess) { grid = -1; return; }
        if (hipOccupancyMaxActiveBlocksPerMultiprocessor(&per_cu, (const void*)fwd_kernel, NTHR, LDS_BYTES) != hipSuccess || per_cu < 1) { fprintf(stderr, "kernel_launch: occupancy query says %d\n", per_cu); }
        (void)hipGetLastError();
        grid = cus;
    }
    if (grid < 0) return;
    if (hipMemsetAsync((char*)d_ws + WS_CTL, 0, CTL_ZERO_BYTES, stream) != hipSuccess) return;
    Args a{};
    for (int i = 0; i < 27; ++i) a.in[i] = (const float*)d_in[i];
    a.out = (float*)d_out; a.ws = (unsigned char*)d_ws; a.pad = 0;
    a.lc_lo = 0; a.lc_hi = DEPTH * NCH; a.ph_lo = 0; a.ph_hi = 12; a.use_bar = 1;
    hipLaunchKernelGGL(fwd_kernel, dim3(grid), dim3(NTHR), LDS_BYTES, stream, a);
}
```

```cpp
#include <hip/hip_runtime.h>
#include <cstdio>
#include <cstdint>
namespace pg8 {
#define PG8_LAS __attribute__((address_space(3)))
typedef unsigned short bf16_t;
typedef short bf16x8 __attribute__((ext_vector_type(8)));
typedef float f32x4 __attribute__((ext_vector_type(4)));
typedef unsigned u32x4 __attribute__((ext_vector_type(4)));
constexpr int BM = 256, BK = 64, HALF = 128, HTB = HALF * BK * 2  , STAGE_BYTES = 8 * HTB, NXCD = 8, WGM = 8;

__host__ __device__ __forceinline__ int lds_byte(int r, int c) { const int st = (r >> 4) * 2 + (c >> 5), rr = r & 15, cc = c & 31, ob = rr * 64 + cc * 2; return st * 1024 + (ob ^ (((ob >> 9) & 1) << 5)); }
__host__ __device__ __forceinline__ void stage_rc(int b, int& R, int& C) { const int st = b / 1024, sb = b % 1024, swz = sb ^ (((sb >> 9) & 1) << 5); R = (st >> 1) * 16 + swz / 64; C = (st & 1) * 32 + (swz % 64) / 2; }
__host__ __device__ __forceinline__ int perm32(int rho) { const int n = rho >> 4, i = rho & 15; return 8 * (i >> 2) + 4 * n + (i & 3); }

struct Unit { int pm, pn; int kb, nk, part; };
struct Gemm { const bf16_t* A; const bf16_t* Bt; int M, N, K; float* pbuf; };

struct StaticOrder {
    static constexpr bool HAS_PARK = false, HAS_MID = false;
    int nM, nN, nwg, G, c;
    __host__ __device__ void init(int M, int N, int G_, int c_) { nM = M / BM; nN = N / BM; nwg = nM * nN; G = G_; c = c_; }
    __host__ __device__ bool next(int i, Unit& u) const {
        const long L = (long)i * G + c; if (L >= nwg) return false;
        int wgid = (int)L; { const int q = nwg / NXCD, r = nwg % NXCD, xcd = wgid % NXCD, off = wgid / NXCD; wgid = (xcd < r ? xcd * (q + 1) : r * (q + 1) + (xcd - r) * q) + off; }
        const int nig = WGM * nN, gid = wgid / nig, fm = gid * WGM, gsz = (nM - fm) < WGM ? (nM - fm) : WGM;
        u.pm = fm + ((wgid % nig) % gsz); u.pn = (wgid % nig) / gsz; u.kb = 0; u.nk = 0; u.part = 0; return true;
    }
    __device__ __forceinline__ void a_ready(const Unit&) const {}
    __device__ __forceinline__ void done(const Unit&) const {}
};
struct StaggerOrder {
    static constexpr bool HAS_PARK = true, HAS_MID = false;
    StaticOrder so; int n, a, nt;
    __host__ __device__ void init(int M, int N, int G_, int c_, int nt_) { so.init(M, N, G_, c_); nt = nt_; n = c_ < so.nwg ? (so.nwg - c_ + G_ - 1) / G_ : 0;
        a = ((c_ & 7) * (nt_ / 8)) & ~3;
        if (a < 4 || nt_ - a < 4 || n < 2) a = 0; }
    __host__ __device__ bool next(int i, Unit& u) const {
        if (a == 0) return so.next(i, u);
        if (i == 0) { so.next(0, u); u.kb = 0; u.nk = a; u.part = 1; return true; }
        if (i < n) return so.next(i, u);
        if (i == n) { so.next(0, u); u.kb = a; u.nk = nt - a; u.part = 2; return true; }
        return false;
    }
    __device__ __forceinline__ void a_ready(const Unit&) const {}
    __device__ __forceinline__ void done(const Unit&) const {}
};


typedef int i32x4 __attribute__((ext_vector_type(4)));
template <bool I8> __device__ __forceinline__ f32x4 mma_op(bf16x8 b, bf16x8 a, f32x4 c) {
    if constexpr (I8) return __builtin_bit_cast(f32x4, __builtin_amdgcn_mfma_i32_16x16x64_i8(__builtin_bit_cast(i32x4, b), __builtin_bit_cast(i32x4, a), __builtin_bit_cast(i32x4, c), 0, 0, 0));
    else return __builtin_amdgcn_mfma_f32_16x16x32_bf16(b, a, c, 0, 0, 0);
}

#ifndef USE_STAGGER
struct GemmOrder : StaticOrder { __host__ __device__ void init(int M, int N, int G_, int c_, int) { StaticOrder::init(M, N, G_, c_); } };
#else
typedef StaggerOrder GemmOrder;
#endif

typedef float f32x2_t __attribute__((ext_vector_type(2))); typedef __bf16 bf16x2_t __attribute__((ext_vector_type(2)));
__device__ __forceinline__ unsigned cvt_pk_bf16(float lo, float hi) { const f32x2_t v = {lo, hi}; const bf16x2_t b = __builtin_convertvector(v, bf16x2_t); return __builtin_bit_cast(unsigned, b); }
__device__ __forceinline__ float sigm(float x) { return __builtin_amdgcn_rcpf(1.0f + __builtin_amdgcn_exp2f(-1.4426950409f * x)); }

struct EpiBf16 {
    static constexpr bool PERM = true, AFTER_DRAIN = false;
    bf16_t* O; int ldc; int skip; int sig_tile;
    int hole_tile, hole_cols;
    __device__ __forceinline__ void mid(f32x4 (&acc)[2][2][4][2], const Unit& u, int wr, int wc, int fr, int fq) const {}
    __device__ __forceinline__ void operator()(const f32x4 (&acc)[2][2][4][2], const Unit& u, int wr, int wc, int fr, int fq) const {
        const int row0 = u.pm * BM + wr * 64 + fr; const int col0 = u.pn * BM + wc * 32 + 8 * fq + (u.pn >= hole_tile ? hole_cols : 0);
#ifdef DBG_NULL_EPI
        if (skip) { asm volatile("" :: "v"(acc[0][0][0][0]), "v"(acc[1][1][3][1])); return; }
#endif
        const bool sg = u.pn >= sig_tile;
#pragma unroll
        for (int ai = 0; ai < 2; ++ai)
#pragma unroll
            for (int m = 0; m < 4; ++m) { bf16_t* rowp = O + (size_t)(row0 + ai * HALF + m * 16) * ldc + col0;
#pragma unroll
                for (int bj = 0; bj < 2; ++bj) { f32x4 v0 = acc[ai][bj][m][0], v1 = acc[ai][bj][m][1];
                    if (sg) {
#pragma unroll
                        for (int j = 0; j < 4; ++j) { v0[j] = sigm(v0[j]); v1[j] = sigm(v1[j]); } }
                    u32x4 w; w.x = cvt_pk_bf16(v0[0], v0[1]); w.y = cvt_pk_bf16(v0[2], v0[3]); w.z = cvt_pk_bf16(v1[0], v1[1]); w.w = cvt_pk_bf16(v1[2], v1[3]);
#if defined(EPI_SC1)
                    asm volatile("global_store_dwordx4 %0, %1, off sc1" :: "v"(rowp + bj * HALF), "v"(w) : "memory");
#elif defined(EPI_NT)
                    __builtin_nontemporal_store(w, (u32x4*)(rowp + bj * HALF));
#else
                    *(u32x4*)(rowp + bj * HALF) = w;
#endif
                    } }
    }
};
struct EpiNull {
    static constexpr bool PERM = true, AFTER_DRAIN = false;
    float* sink;
    __device__ __forceinline__ void mid(f32x4 (&acc)[2][2][4][2], const Unit& u, int wr, int wc, int fr, int fq) const {}
    __device__ __forceinline__ void operator()(const f32x4 (&acc)[2][2][4][2], const Unit& u, int wr, int wc, int fr, int fq) const {
#pragma unroll
        for (int ai = 0; ai < 2; ++ai)
#pragma unroll
            for (int m = 0; m < 4; ++m)
#pragma unroll
                for (int bj = 0; bj < 2; ++bj) { asm volatile("" :: "v"(acc[ai][bj][m][0]), "v"(acc[ai][bj][m][1])); }
    }
};
struct EpiGateI8 {
    static constexpr bool PERM = true, AFTER_DRAIN = false;
    bf16_t* O; int ldc; int col_off; const float* sa; const float* sb;
    __device__ __forceinline__ void dequant(f32x4 (&acc)[2][2][4][2], const Unit& u, int wr, int wc, int fr, int fq) const {}
    __device__ __forceinline__ void mid(f32x4 (&acc)[2][2][4][2], const Unit& u, int wr, int wc, int fr, int fq) const {}
    __device__ __forceinline__ void operator()(const f32x4 (&acc)[2][2][4][2], const Unit& u, int wr, int wc, int fr, int fq) const {
        asm volatile("" : "+v"(fr), "+v"(fq));
        const int row0 = u.pm * BM + wr * 64 + fr; const int col0 = u.pn * BM + wc * 32 + 8 * fq;
        f32x4 sbv[2][2];
#pragma unroll
        for (int bj = 0; bj < 2; ++bj)
#pragma unroll
            for (int n = 0; n < 2; ++n) sbv[bj][n] = *(const f32x4*)(sb + col0 + bj * HALF + 4 * n);
#pragma unroll
        for (int ai = 0; ai < 2; ++ai)
#pragma unroll
            for (int m = 0; m < 4; ++m) { const int row = row0 + ai * HALF + m * 16; const float s = sa[row]; bf16_t* rowp = O + (size_t)row * ldc + col0 + (u.pn < 8 ? 2048 : 4096);
                if (u.pn >= 16 && u.pn < 32) {
                    bf16_t* gp = O + (size_t)row * ldc + 8192 + (u.pn - 16) * HALF + wc * 32 + 8 * fq;
                    const i32x4 a0 = __builtin_bit_cast(i32x4, acc[ai][0][m][0]), a1 = __builtin_bit_cast(i32x4, acc[ai][0][m][1]), b0 = __builtin_bit_cast(i32x4, acc[ai][1][m][0]), b1 = __builtin_bit_cast(i32x4, acc[ai][1][m][1]);
                    const f32x4 ta0 = sbv[0][0] * s, ta1 = sbv[0][1] * s, tb0 = sbv[1][0] * s, tb1 = sbv[1][1] * s; float r[8], g1[8];
#pragma unroll
                    for (int j = 0; j < 4; ++j) {
                        const float h0 = 1.0f + __builtin_amdgcn_exp2f(-1.4426950409f * ((float)b0[j] * tb0[j])), h1 = 1.0f + __builtin_amdgcn_exp2f(-1.4426950409f * ((float)b1[j] * tb1[j]));
                        g1[j] = __builtin_amdgcn_rcpf(h0); g1[4 + j] = __builtin_amdgcn_rcpf(h1);
                        r[j] = sigm((float)a0[j] * ta0[j]) * h0; r[4 + j] = sigm((float)a1[j] * ta1[j]) * h1; }
                    u32x4 w; w.x = cvt_pk_bf16(r[0], r[1]); w.y = cvt_pk_bf16(r[2], r[3]); w.z = cvt_pk_bf16(r[4], r[5]); w.w = cvt_pk_bf16(r[6], r[7]);
                    *(u32x4*)gp = w;
                    w.x = cvt_pk_bf16(g1[0], g1[1]); w.y = cvt_pk_bf16(g1[2], g1[3]); w.z = cvt_pk_bf16(g1[4], g1[5]); w.w = cvt_pk_bf16(g1[6], g1[7]);
                    *(u32x4*)(gp + 2048) = w;
                    continue; }
#pragma unroll
                for (int bj = 0; bj < 2; ++bj) { const i32x4 i0 = __builtin_bit_cast(i32x4, acc[ai][bj][m][0]), i1 = __builtin_bit_cast(i32x4, acc[ai][bj][m][1]);
                    const f32x4 t0 = sbv[bj][0] * s, t1 = sbv[bj][1] * s; float v[8];
#pragma unroll
                    for (int j = 0; j < 4; ++j) { v[j] = (float)i0[j] * t0[j]; v[4 + j] = (float)i1[j] * t1[j]; }
                    if (u.pn >= 16) {
#pragma unroll
                        for (int j = 0; j < 8; ++j) v[j] = sigm(v[j]); }
                    u32x4 w; w.x = cvt_pk_bf16(v[0], v[1]); w.y = cvt_pk_bf16(v[2], v[3]); w.z = cvt_pk_bf16(v[4], v[5]); w.w = cvt_pk_bf16(v[6], v[7]);
                    *(u32x4*)(rowp + bj * HALF) = w; } }
    }
};
struct EpiGlu {
    static constexpr bool PERM = true, AFTER_DRAIN = false;
    bf16_t* O; int ldc;
    __device__ __forceinline__ void mid(f32x4 (&acc)[2][2][4][2], const Unit& u, int wr, int wc, int fr, int fq) const {}
    __device__ __forceinline__ void operator()(const f32x4 (&acc)[2][2][4][2], const Unit& u, int wr, int wc, int fr, int fq) const {
        const int row0 = u.pm * BM + wr * 64 + fr; const int col0 = u.pn * HALF + wc * 32 + 8 * fq;
#pragma unroll
        for (int ai = 0; ai < 2; ++ai)
#pragma unroll
            for (int m = 0; m < 4; ++m) { bf16_t* rowp = O + (size_t)(row0 + ai * HALF + m * 16) * ldc + col0;
                const f32x4 a0 = acc[ai][0][m][0], a1 = acc[ai][0][m][1], g0 = acc[ai][1][m][0], g1 = acc[ai][1][m][1];
                float o[8];
#pragma unroll
                for (int j = 0; j < 4; ++j) { o[j] = a0[j] * sigm(g0[j]); o[4 + j] = a1[j] * sigm(g1[j]); }
                u32x4 w; w.x = cvt_pk_bf16(o[0], o[1]); w.y = cvt_pk_bf16(o[2], o[3]); w.z = cvt_pk_bf16(o[4], o[5]); w.w = cvt_pk_bf16(o[6], o[7]);
                *(u32x4*)rowp = w; }
    }
};
template <int CTRL> __device__ __forceinline__ float dpp_mov_old(float oldv, float x) {
    return __builtin_bit_cast(float, __builtin_amdgcn_update_dpp(__builtin_bit_cast(int, oldv), __builtin_bit_cast(int, x), CTRL, 0xf, 0xf, false)); }
template <int CTRL> __device__ __forceinline__ float dpp_mov_any(float x) {
    return __builtin_bit_cast(float, __builtin_amdgcn_mov_dpp(__builtin_bit_cast(int, x), CTRL, 0xf, 0xf, false)); }
__device__ __forceinline__ float gelu_mul(float a, float v) {
    const float t = a * ((a * a) * -0.1029432396f + -2.3022081986f);
    return (a * v) * __builtin_amdgcn_rcpf(1.0f + __builtin_amdgcn_exp2f(t)); }
__device__ __forceinline__ float gelu_t(float a) { const float u = a * (1.0f + 0.044715f * a * a); return a * sigm(1.5957691216f * u); }
typedef unsigned u32x2 __attribute__((ext_vector_type(2)));
template <bool Q8> struct EpiUpConv {
    static constexpr bool PERM = true, AFTER_DRAIN = false;
    bf16_t* act; bf16_t* raw; const float* cw; const float* cb; int dff, nup;
    const float* sa; const float* sb;
    __device__ __forceinline__ void dequant(f32x4 (&acc)[2][2][4][2], const Unit& u, int wr, int wc, int fr, int fq) const {
    }
    __device__ __forceinline__ void mid(f32x4 (&acc)[2][2][4][2], const Unit& u, int wr, int wc, int fr, int fq) const {}
    __device__ __forceinline__ void operator()(const f32x4 (&acc)[2][2][4][2], const Unit& u, int wr, int wc, int fr, int fq) const {
        asm volatile("" : "+v"(fr), "+v"(fq));
        const int cl0 = u.pn * HALF + wc * 32 + 8 * fq;
#pragma unroll
        for (int ai = 0; ai < 2; ++ai) {
            const int rowb = u.pm * BM + ai * HALF + wr * 64;
            float sr[4];
#pragma unroll
            for (int m = 0; m < 4; ++m) sr[m] = Q8 ? sa[rowb + 16 * m + fr] : 1.0f;
#pragma unroll
            for (int n = 0; n < 2; ++n) {
                const int cl = cl0 + 4 * n;
                f32x4 wa[3], wv[3];
#pragma unroll
                for (int jj = 0; jj < 3; ++jj) { wa[jj] = *(const f32x4*)(cw + (size_t)jj * nup + cl); wv[jj] = *(const f32x4*)(cw + (size_t)jj * nup + dff + cl); }
                const f32x4 ba = *(const f32x4*)(cb + cl), bv = *(const f32x4*)(cb + dff + cl);
                if (Q8) { const f32x4 sba = *(const f32x4*)(sb + u.pn * BM + wc * 32 + 8 * fq + 4 * n), sbv = *(const f32x4*)(sb + u.pn * BM + HALF + wc * 32 + 8 * fq + 4 * n);
#pragma unroll
                    for (int jj = 0; jj < 3; ++jj) { wa[jj] = wa[jj] * sba; wv[jj] = wv[jj] * sbv; } }
                float o[4][4];
#pragma unroll
                for (int j = 0; j < 4; ++j) {
                    float pa = 0.f, pv = 0.f;
#pragma unroll
                    for (int m = 0; m < 4; ++m) {
                        const i32x4 ia_ = __builtin_bit_cast(i32x4, acc[ai][0][m][n]), iv_ = __builtin_bit_cast(i32x4, acc[ai][1][m][n]);
                        const float xa = Q8 ? (float)ia_[j] * sr[m] : acc[ai][0][m][n][j];
                        const float xv = Q8 ? (float)iv_[j] * sr[m] : acc[ai][1][m][n][j];
                        const float a1 = dpp_mov_old<0x111>(dpp_mov_any<0x121>(pa), xa), a2 = dpp_mov_old<0x112>(dpp_mov_any<0x122>(pa), xa);
                        const float v1 = dpp_mov_old<0x111>(dpp_mov_any<0x121>(pv), xv), v2 = dpp_mov_old<0x112>(dpp_mov_any<0x122>(pv), xv);
                        const float ya = wa[0][j] * a2 + (wa[1][j] * a1 + (wa[2][j] * xa + ba[j]));
                        const float yv = wv[0][j] * v2 + (wv[1][j] * v1 + (wv[2][j] * xv + bv[j]));
                        o[m][j] = gelu_mul(ya, yv);
                        pa = xa; pv = xv; } }
#pragma unroll
                for (int m = 0; m < 4; ++m) { u32x2 w2; w2.x = cvt_pk_bf16(o[m][0], o[m][1]); w2.y = cvt_pk_bf16(o[m][2], o[m][3]);
                    *(u32x2*)(act + (size_t)(rowb + 16 * m + fr) * dff + cl) = w2; }
                asm volatile("" ::: "memory");
            }
            const int ridx = fr < 2 ? fr : fr - 12;
            if (fr < 2 || fr >= 14) { const int m = fr < 2 ? 0 : 3;
                f32x4 a0 = fr < 2 ? acc[ai][0][0][0] : acc[ai][0][3][0], a1 = fr < 2 ? acc[ai][0][0][1] : acc[ai][0][3][1];
                f32x4 v0 = fr < 2 ? acc[ai][1][0][0] : acc[ai][1][3][0], v1 = fr < 2 ? acc[ai][1][0][1] : acc[ai][1][3][1];
                if (Q8) { const float s = fr < 2 ? sr[0] : sr[3]; const float* sbp = sb + u.pn * BM + wc * 32 + 8 * fq;
                    const f32x4 sa0 = *(const f32x4*)sbp, sa1 = *(const f32x4*)(sbp + 4), sv0 = *(const f32x4*)(sbp + HALF), sv1 = *(const f32x4*)(sbp + HALF + 4);
                    const i32x4 ia0 = __builtin_bit_cast(i32x4, a0), ia1 = __builtin_bit_cast(i32x4, a1), iv0 = __builtin_bit_cast(i32x4, v0), iv1 = __builtin_bit_cast(i32x4, v1);
                    a0 = (f32x4){(float)ia0[0], (float)ia0[1], (float)ia0[2], (float)ia0[3]} * (sa0 * s); a1 = (f32x4){(float)ia1[0], (float)ia1[1], (float)ia1[2], (float)ia1[3]} * (sa1 * s);
                    v0 = (f32x4){(float)iv0[0], (float)iv0[1], (float)iv0[2], (float)iv0[3]} * (sv0 * s); v1 = (f32x4){(float)iv1[0], (float)iv1[1], (float)iv1[2], (float)iv1[3]} * (sv1 * s); }
                bf16_t* rp = raw + ((size_t)(rowb >> 6) * 4 + ridx) * 2 * dff + cl0; (void)m;
                *(u32x4*)rp = (u32x4){cvt_pk_bf16(a0[0], a0[1]), cvt_pk_bf16(a0[2], a0[3]), cvt_pk_bf16(a1[0], a1[1]), cvt_pk_bf16(a1[2], a1[3])};
                *(u32x4*)(rp + dff) = (u32x4){cvt_pk_bf16(v0[0], v0[1]), cvt_pk_bf16(v0[2], v0[3]), cvt_pk_bf16(v1[0], v1[1]), cvt_pk_bf16(v1[2], v1[3])}; }
        }
    }
};
struct EpiBranch {
    static constexpr bool PERM = true, AFTER_DRAIN = false;
    const bf16_t* proj; int ldp; int gate_col; bf16_t* merged; const bf16_t* ones;
    __device__ __forceinline__ void mid(f32x4 (&acc)[2][2][4][2], const Unit& u, int wr, int wc, int fr, int fq) const {
        const int n = u.pn >> 3, pn = u.pn & 7, pm = u.pm & 31;
        const int row0 = pm * BM + wr * 64 + fr; const int col0 = pn * BM + wc * 32 + 8 * fq;
#pragma unroll
        for (int ai = 0; ai < 2; ++ai)
#pragma unroll
            for (int mp = 0; mp < 1; ++mp) {
                u32x4 ga[4][2], gb[4][2];
#pragma unroll
                for (int mm = 0; mm < 4; ++mm)
#pragma unroll
                    for (int bj = 0; bj < 2; ++bj) { const bf16_t* gp = proj + (size_t)(row0 + ai * HALF + mm * 16) * ldp + gate_col + n * 2048 + col0 + bj * HALF;
                        ga[mm][bj] = *(const u32x4*)gp; gb[mm][bj] = *(const u32x4*)(n == 0 ? ones : gp + 2048); }
#pragma unroll
                for (int mm = 0; mm < 4; ++mm)
#pragma unroll
                    for (int bj = 0; bj < 2; ++bj) { const int m = mm; const u32x4 a = ga[mm][bj], b = gb[mm][bj];
                        f32x4 v0 = acc[ai][bj][m][0], v1 = acc[ai][bj][m][1];
                        v0[0] *= __uint_as_float(a.x << 16) * __builtin_amdgcn_rcpf(__uint_as_float(b.x << 16)); v0[1] *= __uint_as_float(a.x & 0xffff0000u) * __builtin_amdgcn_rcpf(__uint_as_float(b.x & 0xffff0000u));
                        v0[2] *= __uint_as_float(a.y << 16) * __builtin_amdgcn_rcpf(__uint_as_float(b.y << 16)); v0[3] *= __uint_as_float(a.y & 0xffff0000u) * __builtin_amdgcn_rcpf(__uint_as_float(b.y & 0xffff0000u));
                        v1[0] *= __uint_as_float(a.z << 16) * __builtin_amdgcn_rcpf(__uint_as_float(b.z << 16)); v1[1] *= __uint_as_float(a.z & 0xffff0000u) * __builtin_amdgcn_rcpf(__uint_as_float(b.z & 0xffff0000u));
                        v1[2] *= __uint_as_float(a.w << 16) * __builtin_amdgcn_rcpf(__uint_as_float(b.w << 16)); v1[3] *= __uint_as_float(a.w & 0xffff0000u) * __builtin_amdgcn_rcpf(__uint_as_float(b.w & 0xffff0000u));
                        acc[ai][bj][m][0] = v0; acc[ai][bj][m][1] = v1; }
                asm volatile("" ::: "memory"); }
    }
    __device__ __forceinline__ void operator()(const f32x4 (&acc)[2][2][4][2], const Unit& u, int wr, int wc, int fr, int fq) const {
        const int n = u.pn >> 3, pn = u.pn & 7, pm = u.pm & 31;
        const int row0 = pm * BM + wr * 64 + fr; const int col0 = pn * BM + wc * 32 + 8 * fq;
#pragma unroll
        for (int ai = 0; ai < 2; ++ai)
#pragma unroll
            for (int m = 0; m < 4; ++m) { const size_t row = (size_t)(row0 + ai * HALF + m * 16);
#pragma unroll
                for (int bj = 0; bj < 2; ++bj) { const int col = col0 + bj * HALF;
                    const u32x4 gw = *(const u32x4*)(proj + row * ldp + gate_col + n * 2048 + col);
                    f32x4 v0 = acc[ai][bj][m][0], v1 = acc[ai][bj][m][1];
                    v0[0] *= __uint_as_float(gw.x << 16); v0[1] *= __uint_as_float(gw.x & 0xffff0000u); v0[2] *= __uint_as_float(gw.y << 16); v0[3] *= __uint_as_float(gw.y & 0xffff0000u);
                    v1[0] *= __uint_as_float(gw.z << 16); v1[1] *= __uint_as_float(gw.z & 0xffff0000u); v1[2] *= __uint_as_float(gw.w << 16); v1[3] *= __uint_as_float(gw.w & 0xffff0000u);
                    u32x4 w; w.x = cvt_pk_bf16(v0[0], v0[1]); w.y = cvt_pk_bf16(v0[2], v0[3]); w.z = cvt_pk_bf16(v1[0], v1[1]); w.w = cvt_pk_bf16(v1[2], v1[3]);
                    *(u32x4*)(merged + row * 2048 + col) = w; }
                if (m == 3) asm volatile("" ::: "memory"); }
    }
};
struct BranchOrder {
    static constexpr bool HAS_PARK = false, HAS_MID = true;
    StaticOrder so; int G, c;
    __host__ __device__ void init(int G_, int c_) { so.init(32 * BM, 8 * BM, 1, 0); G = G_; c = c_; }
    __host__ __device__ bool next(int i, Unit& u) const {
        const int tile = (i / 3) * G + c, n = i % 3; if (tile >= 256) return false;
        Unit t; so.next(tile, t); u = t; u.pm = t.pm + 32 * n; u.pn = t.pn + 8 * n; u.part = n < 2 ? 3 : 0; return true;
    }
    __device__ __forceinline__ void a_ready(const Unit&) const {}
    __device__ __forceinline__ void done(const Unit&) const {}
};
template <class Epi, class Sched, bool ALIGN_EPI = false, bool SP2 = false, bool I8 = false>
__device__ __forceinline__ void gemm_phase(PG8_LAS unsigned char* lds, const Gemm g, const Sched& S, const Epi& E) {
    int tid_ = threadIdx.x; asm volatile("" : "+v"(tid_)); const int tid = tid_, wid = __builtin_amdgcn_readfirstlane(tid >> 6), lane = tid & 63, wr = wid >> 2, wc = wid & 3, fr = lane & 15, fq = lane >> 4;
    const int K = I8 ? g.K / 2 : g.K, nt = K / BK;
    unsigned voffA[2], voffB[2];
#pragma unroll
    for (int i = 0; i < 2; ++i) { int R, C; stage_rc(tid * 16 + i * 8192, R, C); const int Rb = Epi::PERM ? ((R & ~31) + perm32(R & 31)) : R;
        voffA[i] = (unsigned)(R * K + C) * 2u; voffB[i] = (unsigned)(Rb * K + C) * 2u; }
    const size_t kstep = (size_t)(BK * 2);
    const size_t hstep = (size_t)HALF * K * 2;
    const size_t tstep = 2 * hstep;
    const unsigned ldsw = (unsigned)wid * 1024u;
    const int aoff = lds_byte(wr * 64 + fr, fq * 8), boff = lds_byte(wc * 32 + fr, fq * 8);
#define PG8_SA(b, h) (((b) * 2 + (h)) * HTB)
#define PG8_SB(b, h) ((4 + (b) * 2 + (h)) * HTB)
#define PG8_STAGE(bufoff, gbase, voff) do { _Pragma("unroll") for (int _i = 0; _i < 2; ++_i) \
        __builtin_amdgcn_global_load_lds((const unsigned*)((const char*)(gbase) + (voff)[_i]), (PG8_LAS unsigned*)(lds + (bufoff) + ldsw + _i * 8192), 16, 0, 0); } while (0)
#define PG8_LDA(dst, b, h) do { _Pragma("unroll") for (int m = 0; m < 4; ++m) _Pragma("unroll") for (int k = 0; k < 2; ++k) dst[m][k] = *(const PG8_LAS bf16x8*)(lds + PG8_SA(b, h) + aoff + m * 2048 + k * 1024); } while (0)
#define PG8_LDB(dst, b, h) do { _Pragma("unroll") for (int n = 0; n < 2; ++n) _Pragma("unroll") for (int k = 0; k < 2; ++k) dst[n][k] = *(const PG8_LAS bf16x8*)(lds + PG8_SB(b, h) + boff + n * 2048 + k * 1024); } while (0)
#define PG8_MMA(ai, bj, At, Bt) do { __builtin_amdgcn_s_setprio(1); _Pragma("unroll") for (int m = 0; m < 4; ++m) _Pragma("unroll") for (int n = 0; n < 2; ++n) _Pragma("unroll") for (int k = 0; k < 2; ++k) \
        acc[ai][bj][m][n] = mma_op<I8>(Bt[n][k], At[m][k], acc[ai][bj][m][n]); __builtin_amdgcn_s_setprio(0); } while (0)
#define PG8_WAIT_V(n) asm volatile("s_waitcnt vmcnt(" #n ")" ::: "memory")
#define PG8_WAIT_L(n) asm volatile("s_waitcnt lgkmcnt(" #n ")" ::: "memory")
#define PG8_BAR __builtin_amdgcn_s_barrier()
#define PG8_SCHED __builtin_amdgcn_sched_barrier(0)
    Unit cur, nxt; int ui = 0;
    if (!S.next(0, cur)) return;
    f32x4 acc[2][2][4][2];
#pragma unroll
    for (int a = 0; a < 2; ++a)
#pragma unroll
        for (int b = 0; b < 2; ++b)
#pragma unroll
            for (int m = 0; m < 4; ++m)
#pragma unroll
                for (int n = 0; n < 2; ++n) acc[a][b][m][n] = (f32x4){0.f, 0.f, 0.f, 0.f};
    bf16x8 At[4][2], B0[2][2], B1[2][2];
    const char* cA = (const char*)g.A + (size_t)cur.pm * tstep + (size_t)cur.kb * kstep; const char* cB = (const char*)g.Bt + (size_t)cur.pn * tstep + (size_t)cur.kb * kstep;
    S.a_ready(cur);
    if constexpr (SP2) {
        PG8_STAGE(PG8_SB(0, 0), cB, voffB); PG8_STAGE(PG8_SB(0, 1), cB + hstep, voffB); PG8_STAGE(PG8_SA(0, 0), cA, voffA); PG8_STAGE(PG8_SA(0, 1), cA + hstep, voffA);
        if (wr == 1) PG8_BAR;
        PG8_WAIT_V(2); PG8_BAR;
        PG8_STAGE(PG8_SB(1, 0), cB + kstep, voffB); PG8_STAGE(PG8_SA(1, 0), cA + kstep, voffA); PG8_STAGE(PG8_SB(1, 1), cB + hstep + kstep, voffB);
        PG8_WAIT_V(6); PG8_BAR;
    } else {
        PG8_STAGE(PG8_SB(0, 0), cB, voffB); PG8_STAGE(PG8_SA(0, 0), cA, voffA); PG8_STAGE(PG8_SB(0, 1), cB + hstep, voffB); PG8_STAGE(PG8_SA(0, 1), cA + hstep, voffA);
        if (wr == 1) PG8_BAR;
        PG8_WAIT_V(4); PG8_BAR;
        PG8_STAGE(PG8_SB(1, 0), cB + kstep, voffB); PG8_STAGE(PG8_SA(1, 0), cA + kstep, voffA); PG8_STAGE(PG8_SB(1, 1), cB + hstep + kstep, voffB);
        PG8_WAIT_V(6); PG8_BAR;
    }
    for (;;) {
        const bool has_next = S.next(ui + 1, nxt);
        const char* nA = has_next ? (const char*)g.A + (size_t)nxt.pm * tstep + (size_t)nxt.kb * kstep : cA; const char* nB = has_next ? (const char*)g.Bt + (size_t)nxt.pn * tstep + (size_t)nxt.kb * kstep : cB;
        const int unt = cur.nk ? cur.nk : nt;
        for (int t = 0; t < unt; t += 2) {
            const bool last = (t == unt - 2);
            const char* a1 = cA + (size_t)(t + 1) * kstep;
            const char* a2 = last ? nA : cA + (size_t)(t + 2) * kstep; const char* b2 = last ? nB : cB + (size_t)(t + 2) * kstep;
            const char* a3 = a2 + kstep; const char* b3 = b2 + kstep;
            if (last && has_next) S.a_ready(nxt);
            if constexpr (SP2) {
            PG8_LDB(B0, 0, 0); PG8_LDB(B1, 0, 1); PG8_SCHED; PG8_LDA(At, 0, 0); PG8_STAGE(PG8_SA(1, 1), a1 + hstep, voffA);
            PG8_WAIT_V(8); PG8_WAIT_L(0); PG8_BAR; PG8_MMA(0, 0, At, B0); PG8_MMA(0, 1, At, B1); PG8_BAR; PG8_SCHED;
            PG8_LDA(At, 0, 1); PG8_STAGE(PG8_SB(0, 0), b2, voffB); PG8_STAGE(PG8_SB(0, 1), b2 + hstep, voffB); PG8_STAGE(PG8_SA(0, 0), a2, voffA);
            PG8_WAIT_V(8); PG8_WAIT_L(0); PG8_BAR; PG8_MMA(1, 0, At, B0); PG8_MMA(1, 1, At, B1); PG8_BAR; PG8_SCHED;
            PG8_LDB(B0, 1, 0); PG8_LDB(B1, 1, 1); PG8_SCHED; PG8_LDA(At, 1, 0); PG8_STAGE(PG8_SA(0, 1), a2 + hstep, voffA);
            PG8_WAIT_V(8); PG8_WAIT_L(0); PG8_BAR; PG8_MMA(0, 0, At, B0); PG8_MMA(0, 1, At, B1); PG8_BAR; PG8_SCHED;
            PG8_LDA(At, 1, 1); PG8_STAGE(PG8_SB(1, 0), b3, voffB); PG8_STAGE(PG8_SB(1, 1), b3 + hstep, voffB); PG8_STAGE(PG8_SA(1, 0), a3, voffA);
            PG8_WAIT_V(8); PG8_WAIT_L(0); PG8_BAR; PG8_MMA(1, 0, At, B0); PG8_MMA(1, 1, At, B1); PG8_BAR; PG8_SCHED;
            } else {
            PG8_LDB(B0, 0, 0); PG8_SCHED; PG8_LDA(At, 0, 0); PG8_STAGE(PG8_SA(1, 1), a1 + hstep, voffA);
            PG8_WAIT_L(8); PG8_BAR; PG8_WAIT_L(0); PG8_MMA(0, 0, At, B0); PG8_BAR; PG8_SCHED;
            PG8_LDB(B1, 0, 1); PG8_STAGE(PG8_SB(0, 0), b2, voffB);
            PG8_BAR; PG8_WAIT_L(0); PG8_MMA(0, 1, At, B1); PG8_BAR;
            PG8_LDA(At, 0, 1); PG8_STAGE(PG8_SA(0, 0), a2, voffA);
            PG8_BAR; PG8_WAIT_L(0); PG8_MMA(1, 0, At, B0); PG8_BAR; PG8_SCHED;
            PG8_STAGE(PG8_SB(0, 1), b2 + hstep, voffB);
            PG8_WAIT_V(6); PG8_BAR; PG8_MMA(1, 1, At, B1); PG8_BAR;
            PG8_LDB(B0, 1, 0); PG8_SCHED; PG8_LDA(At, 1, 0); PG8_STAGE(PG8_SA(0, 1), a2 + hstep, voffA);
            PG8_WAIT_L(8); PG8_BAR; PG8_WAIT_L(0); PG8_MMA(0, 0, At, B0); PG8_BAR; PG8_SCHED;
            PG8_LDB(B1, 1, 1); PG8_STAGE(PG8_SB(1, 0), b3, voffB);
            PG8_BAR; PG8_WAIT_L(0); PG8_MMA(0, 1, At, B1); PG8_BAR;
            PG8_LDA(At, 1, 1); PG8_STAGE(PG8_SA(1, 0), a3, voffA);
            PG8_BAR; PG8_WAIT_L(0); PG8_MMA(1, 0, At, B0); PG8_BAR; PG8_SCHED;
            PG8_STAGE(PG8_SB(1, 1), b3 + hstep, voffB);
            PG8_WAIT_V(6); PG8_BAR; PG8_MMA(1, 1, At, B1); PG8_BAR;
            }
        }
        if constexpr (ALIGN_EPI) { if (wr == 0) PG8_BAR; }
        if constexpr (!Epi::AFTER_DRAIN) {
            if (Sched::HAS_PARK && cur.part == 1) {
                char* pb = (char*)g.pbuf + tid * 16;
#pragma unroll
                for (int a = 0; a < 2; ++a)
#pragma unroll
                    for (int b = 0; b < 2; ++b)
#pragma unroll
                        for (int m = 0; m < 4; ++m)
#pragma unroll
                            for (int n = 0; n < 2; ++n) { *(f32x4*)pb = acc[a][b][m][n]; pb += 8192; asm volatile("" : "+v"(pb)); }
            } else if (Sched::HAS_MID && cur.part == 3) { E.mid(acc, cur, wr, wc, fr, fq);
            } else { if constexpr (I8) E.dequant(acc, cur, wr, wc, fr, fq); E(acc, cur, wr, wc, fr, fq); S.done(cur); } }
        if (!has_next) break;
        if (Sched::HAS_PARK && nxt.part == 2) {
            const char* pb = (const char*)g.pbuf + tid * 16;
#pragma unroll
            for (int a = 0; a < 2; ++a)
#pragma unroll
                for (int b = 0; b < 2; ++b)
#pragma unroll
                    for (int m = 0; m < 4; ++m)
#pragma unroll
                        for (int n = 0; n < 2; ++n) { acc[a][b][m][n] = *(const f32x4*)pb; pb += 8192; asm volatile("" : "+v"(pb)); }
        } else if (!(Sched::HAS_MID && cur.part == 3))
#pragma unroll
        for (int a = 0; a < 2; ++a)
#pragma unroll
            for (int b = 0; b < 2; ++b)
#pragma unroll
                for (int m = 0; m < 4; ++m)
#pragma unroll
                    for (int n = 0; n < 2; ++n) acc[a][b][m][n] = (f32x4){0.f, 0.f, 0.f, 0.f};
        cur = nxt; cA = nA; cB = nB; ++ui;
        if constexpr (ALIGN_EPI) { if (wr == 1) PG8_BAR; }
    }
    PG8_WAIT_V(0);
    if constexpr (!ALIGN_EPI) { if (wr == 0) PG8_BAR; }
    PG8_BAR;
    if constexpr (Epi::AFTER_DRAIN) { E.fused(acc, cur, wr, wc, fr, fq, lds, wid, lane); S.done(cur); }
#undef PG8_SA
#undef PG8_SB
#undef PG8_STAGE
#undef PG8_LDA
#undef PG8_LDB
#undef PG8_MMA
#undef PG8_WAIT_V
#undef PG8_WAIT_L
#undef PG8_BAR
#undef PG8_SCHED
}
}

constexpr int D = 2048, NBATCH = 16, L = 2048, M = NBATCH * L;
constexpr int MC = 8192, NCH = 4, DEPTH = 2;
constexpr int NIN = 14344, NP = 14336;
constexpr int C_QM = 0, C_KM = 1024, C_VM = 2048, C_OM = 3072, C_QD = 4096, C_KD = 5120, C_VD = 6144, C_US = 7168, C_GATE = 8192;
constexpr int DFF = 5632, NUP = 2 * DFF;
constexpr float EPS = 1e-6f;
constexpr int NWAVES = 8, NTHR = 512;

constexpr size_t MiB = 1u << 20;
constexpr size_t WS_CTL = 0, CTL_ZERO_BYTES = 1 * MiB;
constexpr size_t WS_TAB = 1 * MiB;
constexpr size_t T_WIF = WS_TAB, T_BIAS = WS_TAB + 131072, T_S5A = WS_TAB + 262144, T_BBT = WS_TAB + 524288, T_CT = WS_TAB + 1048576;
constexpr size_t T_SA_FFN = 2560 * 1024, T_SA_MIX = 2688 * 1024, T_SB_UP = 2816 * 1024, T_SB_G = 2880 * 1024, T_ONES = 2944 * 1024, T_LAM = 2945 * 1024;
constexpr size_t WS_XN8F = 150 * MiB + 64 * MiB;
constexpr size_t WS_WIN = 4 * MiB, WS_WGLU = 60 * MiB, WS_WB = 64 * MiB, WS_WOUT = 76 * MiB, WS_WUP = 84 * MiB, WS_WDN = 128 * MiB;
constexpr size_t WS_XN = 150 * MiB, WS_IFG = 278 * MiB;
constexpr size_t WS_PROJ = 280 * MiB, WS_QKC = 504 * MiB, WS_HM = 536 * MiB, WS_O12 = 552 * MiB, WS_YS5 = 584 * MiB, WS_Y = 600 * MiB, WS_MERGED = 648 * MiB;
constexpr size_t WS_XN8M = 776 * MiB;
constexpr size_t WS_WG8 = 4 * MiB + 16 * MiB;
constexpr size_t WS_MIX = 280 * MiB;
constexpr int MH = 16384;
constexpr size_t WS_ACT = 280 * MiB, WS_FFN = 456 * MiB;
constexpr size_t WS_XB = 872 * MiB;
constexpr size_t WS_PBUF = 0;
constexpr size_t WS_RAW = 1000 * MiB;
constexpr size_t WS_END = 1022 * MiB;
static_assert(WS_WIN + (size_t)NP * D * 2 <= WS_WGLU && WS_WGLU + (size_t)2048 * 1024 * 2 <= WS_WB && WS_WB + (size_t)3 * 2048 * 1024 * 2 <= WS_WOUT && WS_WOUT + (size_t)D * D * 2 <= WS_WUP && WS_WUP + (size_t)NUP * D * 2 <= WS_WDN && WS_WDN + (size_t)D * DFF * 2 <= WS_XN, "ws map: weights");
static_assert(WS_XN + (size_t)M * D * 2 <= WS_IFG && WS_PROJ + (size_t)MC * NP * 2 <= WS_QKC && WS_Y + (size_t)3 * MC * 1024 * 2 <= WS_MERGED && WS_MERGED + (size_t)M * D * 2 <= WS_XN8M, "ws map: mixer");
static_assert(WS_MIX + (size_t)M * D * 2 <= WS_MERGED && WS_ACT + (size_t)MH * DFF * 2 <= WS_FFN && WS_FFN + (size_t)MH * D * 2 <= WS_XN8M && WS_XN8M + (size_t)M * D <= WS_XB && WS_XB + (size_t)M * D * 2 <= WS_END, "ws map: ffn");
constexpr int CW_QUEUE = 64;
constexpr int CW_BAR = 4096;
constexpr int CW_COLMAX = 65536, NI8 = 10240;

constexpr int LDS_BYTES = 147456, LDSCTL_OFF = 143360;

#define GAS __attribute__((address_space(1)))
#define LAS __attribute__((address_space(3)))
#define DI __device__ __forceinline__
typedef unsigned short bf16;
typedef unsigned v4u __attribute__((ext_vector_type(4)));
typedef unsigned v2u __attribute__((ext_vector_type(2)));
typedef float f32x4 __attribute__((ext_vector_type(4)));
typedef float f32x2 __attribute__((ext_vector_type(2)));
typedef short bf16x8 __attribute__((ext_vector_type(8)));
typedef short s16x4 __attribute__((ext_vector_type(4)));
typedef GAS unsigned gu32;
#define RLX_AGENT __ATOMIC_RELAXED, __HIP_MEMORY_SCOPE_AGENT
#define LDS_WAIT() asm volatile("s_waitcnt lgkmcnt(0)" ::: "memory")
#ifdef P0_NT_LD
#define P0_LD(p_) __builtin_nontemporal_load(p_)
#else
#define P0_LD(p_) (*(p_))
#endif
#define VM_WAIT() asm volatile("s_waitcnt vmcnt(0)" ::: "memory")
#define MFMA16(a, b, c) __builtin_amdgcn_mfma_f32_16x16x32_bf16((a), (b), (c), 0, 0, 0)
#define SB() __builtin_amdgcn_sched_barrier(0)
#ifndef NOSB1
#define SB1() SB()
#else
#define SB1()
#endif
#if 0
#define SB2() SB()
#else
#define SB2()
#endif
#ifndef NOSB3
#define SB3() SB()
#else
#define SB3()
#endif
DI unsigned f2bf(float f) { unsigned u = __builtin_bit_cast(unsigned, f); return (u + 0x7fffu + ((u >> 16) & 1u)) >> 16; }
DI unsigned pk2(float lo, float hi) { return pg8::cvt_pk_bf16(lo, hi); }
DI float bflo(unsigned w) { return __uint_as_float(w << 16); }
DI float bfhi(unsigned w) { return __uint_as_float(w & 0xffff0000u); }
DI float bf2f(bf16 b) { return __uint_as_float(((unsigned)b) << 16); }
DI float ex2(float x) { return __builtin_amdgcn_exp2f(x); }
DI float expf_(float x) { return __builtin_amdgcn_exp2f(x * 1.4426950409f); }
DI float sigm(float x) { return __builtin_amdgcn_rcpf(1.0f + __builtin_amdgcn_exp2f(-1.4426950409f * x)); }
DI float gelu_tanh(float a) { const float u = a * (1.0f + 0.044715f * a * a); return a * sigm(1.5957691216f * u); }
DI float wave_sum(float v) {
#pragma unroll
    for (int o = 1; o < 64; o <<= 1) v += __shfl_xor(v, o);
    return v;
}
DI float wave_max(float v) {
#pragma unroll
    for (int o = 1; o < 64; o <<= 1) v = fmaxf(v, __shfl_xor(v, o));
    return v;
}
DI unsigned pack_i8(f32x4 v, float inv) {
    const int a = (int)__builtin_rintf(v.x * inv), b = (int)__builtin_rintf(v.y * inv), c = (int)__builtin_rintf(v.z * inv), d = (int)__builtin_rintf(v.w * inv);
    return (unsigned)(a & 255) | ((unsigned)(b & 255) << 8) | ((unsigned)(c & 255) << 16) | ((unsigned)d << 24);
}
DI bf16x8 tr8(const LAS unsigned char* p0, const LAS unsigned char* p1) {
    typedef short v4i16_t __attribute__((ext_vector_type(4)));
    const s16x4 lo = __builtin_bit_cast(s16x4, __builtin_amdgcn_ds_read_tr16_b64_v4i16((LAS v4i16_t*)p0));
    const s16x4 hi = __builtin_bit_cast(s16x4, __builtin_amdgcn_ds_read_tr16_b64_v4i16((LAS v4i16_t*)p1));
    return __builtin_shufflevector(lo, hi, 0, 1, 2, 3, 4, 5, 6, 7);
}

struct Frame {
    LAS unsigned char* lds;
    volatile LAS unsigned* MISC;
    gu32* ctl;
    int tid, lane, wave, G, bid;
    unsigned char* ws;
    const float* const* in;
    float* out;
};

DI void p0_transpose_item(const float* W, int ldw, int K, int src_col0, bf16* WT, int dst_row0, LAS float* scr, int kb, int lane) {
    const int k0 = 64 * kb, kr = lane >> 3, nc = lane & 7;
    f32x4 v[8];
#pragma unroll
    for (int i = 0; i < 8; ++i) v[i] = P0_LD((const GAS f32x4*)(W + (size_t)(k0 + kr + 8 * i) * ldw + src_col0 + 4 * nc));
#pragma unroll
    for (int i = 0; i < 8; ++i) *(LAS f32x4*)(scr + (kr + 8 * i) * 36 + 4 * nc) = v[i];
    LDS_WAIT(); asm volatile("" ::: "memory");
    const int c = lane & 7;
#pragma unroll
    for (int j = 0; j < 4; ++j) { const int n = (lane >> 3) + 8 * j; const LAS float* s = scr + (8 * c) * 36 + n;
        v4u o; o.x = pk2(s[0 * 36], s[1 * 36]); o.y = pk2(s[2 * 36], s[3 * 36]); o.z = pk2(s[4 * 36], s[5 * 36]); o.w = pk2(s[6 * 36], s[7 * 36]);
        *(GAS v4u*)(WT + (size_t)(dst_row0 + n) * K + k0 + 8 * c) = o; }
    LDS_WAIT(); asm volatile("" ::: "memory");
}
DI void rms_row_to_bf16(const float* xrow, const float* gain, bf16* orow, int lane, unsigned char* o8 = nullptr, float* sa = nullptr) {
    f32x4 v[8]; float s = 0.f;
#pragma unroll
    for (int j = 0; j < 8; ++j) { v[j] = __builtin_nontemporal_load((const GAS f32x4*)(xrow + 4 * (lane + 64 * j))); s += (v[j].x * v[j].x + v[j].y * v[j].y) + (v[j].z * v[j].z + v[j].w * v[j].w); }
    const float rstd = 1.0f / sqrtf(wave_sum(s) * (1.0f / D) + EPS);
#pragma unroll
    for (int j = 0; j < 8; ++j) { const f32x4 g0 = *(const GAS f32x4*)(gain + 4 * (lane + 64 * j)); const f32x4 a = v[j] * rstd * g0; v[j] = a;
        __builtin_nontemporal_store(((v2u){pk2(a.x, a.y), pk2(a.z, a.w)}), (GAS v2u*)(orow + 4 * (lane + 64 * j))); }
    if (o8) { float mx = 0.f;
#pragma unroll
        for (int j = 0; j < 8; ++j) mx = fmaxf(fmaxf(mx, fmaxf(fabsf(v[j].x), fabsf(v[j].y))), fmaxf(fabsf(v[j].z), fabsf(v[j].w)));
        mx = wave_max(mx); const float inv = mx > 0.f ? 127.0f / mx : 0.f;
#pragma unroll
        for (int j = 0; j < 8; ++j) __builtin_nontemporal_store(pack_i8(v[j], inv), (GAS unsigned*)(o8 + 4 * (lane + 64 * j)));
        if (lane == 0) *sa = mx * (1.0f / 127.0f); }
}
DI void p0_colmax_item(const float* W, int ldw, int src_col0, unsigned* cmax, int dst_row0, int kb, int lane) {
    const int k0 = 64 * kb, kr = lane >> 3, nc = lane & 7;
    f32x4 mx = (f32x4){0.f, 0.f, 0.f, 0.f};
#pragma unroll
    for (int i = 0; i < 8; ++i) { const f32x4 v = *(const GAS f32x4*)(W + (size_t)(k0 + kr + 8 * i) * ldw + src_col0 + 4 * nc);
        mx.x = fmaxf(mx.x, fabsf(v.x)); mx.y = fmaxf(mx.y, fabsf(v.y)); mx.z = fmaxf(mx.z, fabsf(v.z)); mx.w = fmaxf(mx.w, fabsf(v.w)); }
#pragma unroll
    for (int o = 8; o < 64; o <<= 1) { mx.x = fmaxf(mx.x, __shfl_xor(mx.x, o)); mx.y = fmaxf(mx.y, __shfl_xor(mx.y, o)); mx.z = fmaxf(mx.z, __shfl_xor(mx.z, o)); mx.w = fmaxf(mx.w, __shfl_xor(mx.w, o)); }
    if (lane < 8) { unsigned* p = cmax + dst_row0 + 4 * nc;
        atomicMax(p, __float_as_uint(mx.x)); atomicMax(p + 1, __float_as_uint(mx.y)); atomicMax(p + 2, __float_as_uint(mx.z)); atomicMax(p + 3, __float_as_uint(mx.w)); }
}
DI void p0_transpose_i8_item(const float* W, int ldw, int K, int src_col0, signed char* WT, const unsigned* cmax, int dst_row0, LAS float* scr, int kb, int lane) {
    const int k0 = 64 * kb, kr = lane >> 3, nc = lane & 7;
    f32x4 v[8];
#pragma unroll
    for (int i = 0; i < 8; ++i) v[i] = *(const GAS f32x4*)(W + (size_t)(k0 + kr + 8 * i) * ldw + src_col0 + 4 * nc);
#pragma unroll
    for (int i = 0; i < 8; ++i) *(LAS f32x4*)(scr + (kr + 8 * i) * 36 + 4 * nc) = v[i];
    LDS_WAIT(); asm volatile("" ::: "memory");
    const int c = lane & 7;
#pragma unroll
    for (int j = 0; j < 4; ++j) { const int n = (lane >> 3) + 8 * j; const LAS float* s = scr + (8 * c) * 36 + n;
        const float cm = __uint_as_float(cmax[dst_row0 + n]), inv = cm > 0.f ? 127.0f / cm : 0.f;
        v2u o; o.x = pack_i8((f32x4){s[0 * 36], s[1 * 36], s[2 * 36], s[3 * 36]}, inv); o.y = pack_i8((f32x4){s[4 * 36], s[5 * 36], s[6 * 36], s[7 * 36]}, inv);
        *(GAS v2u*)(WT + (size_t)(dst_row0 + n) * K + k0 + 8 * c) = o; }
    LDS_WAIT(); asm volatile("" ::: "memory");
}
DI void p0_strip_i8(Frame& F, const float* W, int ldw, int src_col0, signed char* WT, float* sb, int dst_row0) {
    const int lane = F.lane, w = F.wave, kr = lane >> 3, nc = lane & 7;
    LAS float* scr = (LAS float*)(F.lds + w * 16384); LAS float* cmx = (LAS float*)(F.lds + 131072);
    f32x4 v[4][8];
    const unsigned off0 = (unsigned)((256 * w + kr) * ldw + src_col0 + 4 * nc) * 4u;
#pragma unroll
    for (int j = 0; j < 4; ++j)
#pragma unroll
        for (int i = 0; i < 8; ++i) v[j][i] = P0_LD((const GAS f32x4*)((const char*)W + (off0 + (unsigned)((64 * j + 8 * i) * ldw) * 4u)));
    f32x4 mx = (f32x4){0.f, 0.f, 0.f, 0.f};
#pragma unroll
    for (int j = 0; j < 4; ++j)
#pragma unroll
        for (int i = 0; i < 8; ++i) { mx.x = fmaxf(mx.x, fabsf(v[j][i].x)); mx.y = fmaxf(mx.y, fabsf(v[j][i].y)); mx.z = fmaxf(mx.z, fabsf(v[j][i].z)); mx.w = fmaxf(mx.w, fabsf(v[j][i].w)); }
#pragma unroll
    for (int o = 8; o < 64; o <<= 1) { mx.x = fmaxf(mx.x, __shfl_xor(mx.x, o)); mx.y = fmaxf(mx.y, __shfl_xor(mx.y, o)); mx.z = fmaxf(mx.z, __shfl_xor(mx.z, o)); mx.w = fmaxf(mx.w, __shfl_xor(mx.w, o)); }
    if (lane < 8) *(LAS f32x4*)(cmx + w * 32 + 4 * nc) = mx;
    __syncthreads();
    float inv[4];
#pragma unroll
    for (int j = 0; j < 4; ++j) { const int n = (lane >> 3) + 8 * j; float cm = 0.f;
#pragma unroll
        for (int ww = 0; ww < 8; ++ww) cm = fmaxf(cm, cmx[ww * 32 + n]);
        inv[j] = cm > 0.f ? 127.0f / cm : 0.f;
        if (w == 0 && (lane & 7) == 0) sb[dst_row0 + n] = cm * (1.0f / 127.0f); }
    const int c = lane & 7;
#pragma unroll
    for (int j4 = 0; j4 < 4; ++j4) {
#pragma unroll
        for (int i = 0; i < 8; ++i) *(LAS f32x4*)(scr + (kr + 8 * i) * 36 + 4 * nc) = v[j4][i];
        LDS_WAIT(); asm volatile("" ::: "memory");
#pragma unroll
        for (int j = 0; j < 4; ++j) { const int n = (lane >> 3) + 8 * j; const LAS float* sp = scr + (8 * c) * 36 + n;
            v2u o; o.x = pack_i8((f32x4){sp[0 * 36], sp[1 * 36], sp[2 * 36], sp[3 * 36]}, inv[j]); o.y = pack_i8((f32x4){sp[4 * 36], sp[5 * 36], sp[6 * 36], sp[7 * 36]}, inv[j]);
            *(GAS v2u*)((char*)WT + (unsigned)((dst_row0 + n) * D + 256 * w + 64 * j4 + 8 * c)) = o; }
        LDS_WAIT(); asm volatile("" ::: "memory"); }
    __syncthreads();
}
DI void p0_weights(Frame& F, int l) {
    for (int sidx = F.bid; sidx < NUP / 32 + NI8 / 32; sidx += F.G) {
        if (sidx < NUP / 32) { const int n0 = 32 * sidx, cc = n0 >= DFF ? n0 - DFF : n0, drow = (cc >> 7) * 256 + (n0 >= DFF ? 128 : 0) + (cc & 127);
            p0_strip_i8(F, F.in[23] + (size_t)l * D * NUP, NUP, n0, (signed char*)(F.ws + WS_WUP), (float*)(F.ws + T_SB_UP), drow); }
        else { const int r8 = 32 * (sidx - NUP / 32);
            int n0 = r8 < 2048 ? r8 + 2048 : r8 + 4096;
            if (r8 >= 4096 && r8 < 8192) { const int q = r8 - 4096, ww = q & 255; n0 = C_GATE + (ww >> 7) * 2048 + 128 * (q >> 8) + (ww & 127); }
            const int oc = n0 < 4096 ? n0 : n0 + 8;
            p0_strip_i8(F, F.in[5] + (size_t)l * D * NIN, NIN, oc, (signed char*)(F.ws + WS_WG8), (float*)(F.ws + T_SB_G), r8); }
    }
    LAS float* scr = (LAS float*)(F.lds + F.wave * 16384);
    const int gw = F.bid * NWAVES + F.wave, NGW = F.G * NWAVES;
    constexpr int I_IN = 32 * 128, I_GLU = 16 * 64, I_B = 3 * 16 * 64, I_OUT = 32 * 64, I_DN = 88 * 64, I_LAYER = I_IN + I_GLU + I_B + I_OUT + I_DN;
    for (int it = gw; it < I_LAYER; it += NGW) {
        int r = it;
        if (r < I_IN) { const int kb = r / 128, nb = r % 128, nd = 32 * nb, n0 = nd < 2048 ? nd : nd + 2048;
            const int oc = n0 < 4096 ? n0 : n0 + 8;
            p0_transpose_item(F.in[5] + (size_t)l * D * NIN, NIN, D, oc, (bf16*)(F.ws + WS_WIN), nd, scr, kb, F.lane);
            continue; } r -= I_IN;
        if (r < I_GLU) { const int kb = r / 64, nb = r % 64, n0 = 32 * nb; const int cc = n0 & 1023, drow = (cc >> 7) * 256 + (n0 >= 1024 ? 128 : 0) + (cc & 127);
            p0_transpose_item(F.in[20] + (size_t)l * 1024 * 2048, 2048, 1024, n0, (bf16*)(F.ws + WS_WGLU), drow, scr, kb, F.lane); continue; } r -= I_GLU;
        if (r < I_B) { const int n = r / 1024, rr = r % 1024, kb = rr / 64, nb = rr % 64;
            p0_transpose_item(F.in[21] + (size_t)(l * 3 + n) * 1024 * 2048, 2048, 1024, 32 * nb, (bf16*)(F.ws + WS_WB) + (size_t)n * 2048 * 1024, 32 * nb, scr, kb, F.lane); continue; } r -= I_B;
        if (r < I_OUT) { const int kb = r / 64, nb = r % 64;
            p0_transpose_item(F.in[22] + (size_t)l * D * D, D, D, 32 * nb, (bf16*)(F.ws + WS_WOUT), 32 * nb, scr, kb, F.lane); continue; } r -= I_OUT;
        { const int kb = r / 64, nb = r % 64;
            p0_transpose_item(F.in[26] + (size_t)l * DFF * D, D, DFF, 32 * nb, (bf16*)(F.ws + WS_WDN), 32 * nb, scr, kb, F.lane); }
    }
}
DI void p0_tables(Frame& F) {
    const int gw = F.bid * NWAVES + F.wave, NGW = F.G * NWAVES;
    const int gt = F.bid * NTHR + F.tid, NGT = F.G * NTHR;
    if (gt < 4) ((unsigned*)(F.ws + T_ONES))[gt] = 0x3F803F80u;
    if (gw < DEPTH) { const int lane = F.lane; const float* lam = F.in[9] + gw * 4 * 128;
        const float s01 = wave_sum(lam[lane] * lam[128 + lane] + lam[64 + lane] * lam[192 + lane]);
        const float s23 = wave_sum(lam[256 + lane] * lam[384 + lane] + lam[320 + lane] * lam[448 + lane]);
        const float lambda_init = 0.8f - 0.6f * expf(-0.3f * (float)gw);
        if (lane == 0) { ((float*)(F.ws + T_LAM))[2 * gw] = expf(s01) - expf(s23) + lambda_init; ((float*)(F.ws + T_LAM))[2 * gw + 1] = 1.0f - lambda_init; } }
    for (int i = gt; i < DEPTH * 8 * D; i += NGT) { const int l = i / (8 * D), j = (i / D) & 7, d = i % D;
        ((float*)(F.ws + T_WIF))[i] = F.in[5][((size_t)l * D + d) * NIN + 4096 + j]; }
    for (int i = gt; i < 4 * 128; i += NGT) { const int h = i >> 7, n = i & 127;
        int bk = n; if (n >= 16) { bk = 16 + (int)(logf((float)n / 16.0f) / 2.0794415416798357f * 16.0f); bk = bk < 31 ? bk : 31; }
        ((float*)(F.ws + T_BIAS))[i] = F.in[11][bk * 4 + h] * 1.4426950409f; }
    for (int i = gt; i < DEPTH * 64 * 64; i += NGT) {
        const int l = i >> 12, g = (i >> 6) & 63, p = i & 63;
        const float lr = F.in[12][i], li = F.in[13][i], dt = expf(F.in[14][l * 64 + g]);
        const float mag = expf(lr * dt), are = mag * cosf(li * dt), aim = mag * sinf(li * dt), den = lr * lr + li * li;
        const float zre = ((are - 1.0f) * lr + aim * li) / den, zim = (aim * lr - (are - 1.0f) * li) / den;
        ((float*)(F.ws + T_S5A))[2 * i] = are; ((float*)(F.ws + T_S5A))[2 * i + 1] = aim;
        bf16* bbt = (bf16*)(F.ws + T_BBT) + ((size_t)(l * 64 + g) * 128 + 2 * p) * 16;
        bf16* ct = (bf16*)(F.ws + T_CT) + (size_t)(l * 64 + g) * 16 * 128;
        for (int c = 0; c < 16; ++c) { const float br = F.in[15][(size_t)i * 16 + c], bi = F.in[16][(size_t)i * 16 + c];
            bbt[c] = (bf16)f2bf(zre * br - zim * bi); bbt[16 + c] = (bf16)f2bf(zre * bi + zim * br);
            const size_t ci = ((size_t)(l * 64 + g) * 16 + c) * 64 + p;
            ct[c * 128 + 2 * p] = (bf16)f2bf(F.in[17][ci]); ct[c * 128 + 2 * p + 1] = (bf16)f2bf(-F.in[18][ci]); }
    }
    for (int m = gw; m < M; m += NGW) rms_row_to_bf16(F.in[0] + (size_t)m * D, F.in[1], (bf16*)(F.ws + WS_XN) + (size_t)m * D, F.lane, F.ws + WS_XN8M + (size_t)m * D, (float*)(F.ws + T_SA_MIX) + m);
}

DI void p2_conv_gates(Frame& F, int layer, int chunk) {
    const bf16* proj = (const bf16*)(F.ws + WS_PROJ); bf16* qkc = (bf16*)(F.ws + WS_QKC);
    const float* cw = F.in[7] + (size_t)layer * 4 * 2048;
    LAS float* wl = (LAS float*)F.lds;
    { const float* wif = (const float*)(F.ws + T_WIF) + (size_t)layer * 8 * D;
      for (int i = F.tid; i < 8 * D / 4; i += NTHR) ((LAS f32x4*)wl)[i] = ((const GAS f32x4*)wif)[i]; }
    const int gt = F.bid * NTHR + F.tid, NGT = F.G * NTHR;
    for (int task = gt; task < 1024 * 256; task += NGT) {
        const int cp = task & 1023, run = task >> 10, r0 = run * 32, t0 = r0 & (L - 1), c = 2 * cp;
        float w0[4], w1[4];
#pragma unroll
        for (int j = 0; j < 4; ++j) { w0[j] = cw[j * 2048 + c]; w1[j] = cw[j * 2048 + c + 1]; }
        const float post = c >= 1024 ? 0.0625f : 1.0f;
        float a0[3], a1[3];
#pragma unroll
        for (int j = 0; j < 3; ++j) { unsigned w = 0u; if (t0 > 0) w = *(const GAS unsigned*)(proj + (size_t)(r0 - 3 + j) * NP + c); a0[j] = bflo(w); a1[j] = bfhi(w); }
        for (int tb = 0; tb < 32; tb += 8) {
          unsigned w8[8];
#pragma unroll
          for (int u = 0; u < 8; ++u) w8[u] = *(const GAS unsigned*)(proj + (size_t)(r0 + tb + u) * NP + c);
#pragma unroll
          for (int u = 0; u < 8; ++u) { const int t = tb + u;
            const unsigned w = w8[u]; const float x0 = bflo(w), x1 = bfhi(w);
            float y0 = w0[0] * a0[0] + w0[1] * a0[1] + w0[2] * a0[2] + w0[3] * x0, y1 = w1[0] * a1[0] + w1[1] * a1[1] + w1[2] * a1[2] + w1[3] * x1;
            y0 = y0 * sigm(y0) * post; y1 = y1 * sigm(y1) * post;
            *(GAS unsigned*)(qkc + (size_t)(r0 + t) * 2048 + c) = pk2(y0, y1);
            a0[0] = a0[1]; a0[1] = a0[2]; a0[2] = x0; a1[0] = a1[1]; a1[1] = a1[2]; a1[2] = x1;
          }
        }
    }
    __syncthreads();
    const bf16* xn = (const bf16*)(F.ws + WS_XN) + (size_t)chunk * MC * D; float* ifg = (float*)(F.ws + WS_IFG) + (size_t)chunk * MC * 8;
    const float* bif = F.in[6] + layer * 8;
    const int gw = F.bid * NWAVES + F.wave, NGW = F.G * NWAVES;
    for (int r = gw; r < MC; r += NGW) {
        float x[32];
#pragma unroll
        for (int j = 0; j < 4; ++j) { const v4u w = *(const GAS v4u*)(xn + (size_t)r * D + 8 * (F.lane + 64 * j));
            x[8 * j] = bflo(w.x); x[8 * j + 1] = bfhi(w.x); x[8 * j + 2] = bflo(w.y); x[8 * j + 3] = bfhi(w.y); x[8 * j + 4] = bflo(w.z); x[8 * j + 5] = bfhi(w.z); x[8 * j + 6] = bflo(w.w); x[8 * j + 7] = bfhi(w.w); }
        float res = 0.f;
#pragma unroll 1
        for (int jg = 0; jg < 8; ++jg) { float s = 0.f;
#pragma unroll
            for (int j = 0; j < 4; ++j) { const f32x4 wa = *(const LAS f32x4*)(wl + jg * D + 8 * (F.lane + 64 * j)), wb = *(const LAS f32x4*)(wl + jg * D + 8 * (F.lane + 64 * j) + 4);
                s += x[8 * j] * wa.x + x[8 * j + 1] * wa.y + x[8 * j + 2] * wa.z + x[8 * j + 3] * wa.w + x[8 * j + 4] * wb.x + x[8 * j + 5] * wb.y + x[8 * j + 6] * wb.z + x[8 * j + 7] * wb.w; }
            s = wave_sum(s); if (F.lane == jg) res = s + bif[jg]; }
        if (F.lane < 8) ifg[(size_t)r * 8 + F.lane] = res;
    }
    __syncthreads();
}

constexpr int ML_QS = 0, ML_KS = 33792, ML_VX = 67584, ML_VW = 77824, ML_SS = 88064, ML_CT = 97280, ML_GT = 139520;
constexpr int ML_P = 528, ML_VP = 160, ML_SP = 144;
DI void mlstm_item(Frame& F, int chunk, int item) {
    const int bl = item >> 4, h = (item >> 2) & 3, sl = item & 3;
    const int lrow0 = bl * L; const size_t grow0 = (size_t)chunk * MC + lrow0;
    const bf16* proj = (const bf16*)(F.ws + WS_PROJ); const bf16* qkc = (const bf16*)(F.ws + WS_QKC); const float* ifg = (const float*)(F.ws + WS_IFG);
    bf16* hm = (bf16*)(F.ws + WS_HM);
    LAS unsigned char* lds = F.lds;
    LAS float* gd = (LAS float*)(lds + ML_GT); LAS float* gM = gd + 64; LAS float* gwt = gd + 128; LAS float* gem = gd + 192;
    const int tid = F.tid, lane = F.lane, w = F.wave, fr = lane & 15, fq = lane >> 4, q4 = fr >> 2, p4 = fr & 3;
    constexpr float LOG2E = 1.4426950408889634f, LN2 = 0.6931471805599453f;
    { unsigned z0 = 0u; asm volatile("" : "+v"(z0));
      for (int i = tid; i < 42240 / 16; i += NTHR) ((LAS v4u*)(lds + ML_CT))[i] = (v4u){z0, z0, z0, z0}; }
    f32x4 Cacc[5][2];
#pragma unroll
    for (int a = 0; a < 5; ++a)
#pragma unroll
        for (int b = 0; b < 2; ++b) Cacc[a][b] = (f32x4){0.f, 0.f, 0.f, 0.f};
    float m_prev = 0.f;
    v4u rq[4], rk[4], rv; float ripre, rfpre;
#define ML_LOAD_KV(t0_) do { ripre = ifg[(grow0 + (t0_) + lane) * 8 + h]; rfpre = ifg[(grow0 + (t0_) + lane) * 8 + 4 + h]; \
        _Pragma("unroll") for (int i = 0; i < 4; ++i) { const int q = tid + NTHR * i, s = q >> 5, c16 = q & 31; rk[i] = *(const GAS v4u*)(qkc + (size_t)(lrow0 + (t0_) + s) * 2048 + 1024 + h * 256 + 8 * c16); } \
        { const int s = tid >> 3, c8 = tid & 7; rv = *(const GAS v4u*)(proj + (size_t)(lrow0 + (t0_) + s) * NP + C_VM + h * 256 + sl * 64 + 8 * c8); } } while (0)
#define ML_LOAD_Q(t0_) do { _Pragma("unroll") for (int i = 0; i < 4; ++i) { const int q = tid + NTHR * i, s = q >> 5, c16 = q & 31; rq[i] = *(const GAS v4u*)(qkc + (size_t)(lrow0 + (t0_) + s) * 2048 + h * 256 + 8 * c16); } } while (0)
    ML_LOAD_KV(0); ML_LOAD_Q(0);
    for (int c = 0; c < L / 64; ++c) {
        const int t0 = 64 * c;
        const float ipre = ripre, fpre = rfpre;
        const float lf = fminf(fpre, 0.f) - LN2 * __builtin_amdgcn_logf(1.0f + ex2(-LOG2E * fabsf(fpre)));
        float b = lf;
#pragma unroll
        for (int o = 1; o < 64; o <<= 1) { const float v = __shfl_up(b, o); if (lane >= o) b += v; }
        const float dd = ipre - b; float pm = dd;
#pragma unroll
        for (int o = 1; o < 64; o <<= 1) { const float v = __shfl_up(pm, o); if (lane >= o) pm = fmaxf(pm, v); }
        const float Mt = fmaxf(m_prev, pm), wt = ex2(LOG2E * (m_prev - Mt)), em = ex2(-LOG2E * (b + Mt));
        const float M63 = __shfl(Mt, 63), g = __shfl(b, 63), wsv = ex2(LOG2E * (dd - M63)), decay = ex2(LOG2E * (m_prev - M63));
        if (w == 0) { gd[lane] = dd * LOG2E; gM[lane] = Mt * LOG2E; gwt[lane] = wt; gem[lane] = em; }
#pragma unroll
        for (int i = 0; i < 4; ++i) { const int q = tid + NTHR * i, s = q >> 5, c16 = q & 31;
            *(LAS v4u*)(lds + ML_QS + s * ML_P + 16 * c16) = rq[i]; *(LAS v4u*)(lds + ML_KS + s * ML_P + 16 * c16) = rk[i]; }
        { const int s = tid >> 3, c8 = tid & 7; const float wss = __shfl(wsv, s & 63);
          const v4u v = rv;
          *(LAS v4u*)(lds + ML_VX + s * ML_VP + 16 * c8) = v;
          v4u o; o.x = pk2(bflo(v.x) * wss, bfhi(v.x) * wss); o.y = pk2(bflo(v.y) * wss, bfhi(v.y) * wss); o.z = pk2(bflo(v.z) * wss, bfhi(v.z) * wss); o.w = pk2(bflo(v.w) * wss, bfhi(v.w) * wss);
          *(LAS v4u*)(lds + ML_VW + s * ML_VP + 16 * c8) = o; }
        if (w == 0) { const int s = lane; unsigned z = 0u; asm volatile("" : "+v"(z));
            *(LAS v4u*)(lds + ML_VX + s * ML_VP + 128) = (v4u){0x3F80u | z, z, z, z}; *(LAS v4u*)(lds + ML_VX + s * ML_VP + 144) = (v4u){z, z, z, z};
            *(LAS v4u*)(lds + ML_VW + s * ML_VP + 128) = (v4u){pk2(wsv, 0.f), z, z, z}; *(LAS v4u*)(lds + ML_VW + s * ML_VP + 144) = (v4u){z, z, z, z}; }
        if (c + 1 < L / 64) ML_LOAD_KV(t0 + 64);
        __syncthreads();
        { const int tb = w >> 1, sb0 = 2 * (w & 1);
          if (sb0 <= tb) {
            const bool two = (sb0 + 1) <= tb;
            const float mt = gM[16 * tb + fr];
            const f32x4 d0 = *(const LAS f32x4*)(gd + 16 * sb0 + 4 * fq), d1 = *(const LAS f32x4*)(gd + 16 * (sb0 + 1) + 4 * fq);
            f32x4 a0 = (f32x4){0.f, 0.f, 0.f, 0.f}, a1 = a0;
#pragma unroll
            for (int hk = 0; hk < 2; ++hk) {
                bf16x8 qa[4], ka[4], kc[4];
#pragma unroll
                for (int k4 = 0; k4 < 4; ++k4) { const int ks = 4 * hk + k4;
                    qa[k4] = *(const LAS bf16x8*)(lds + ML_QS + (16 * tb + fr) * ML_P + (32 * ks + 8 * fq) * 2);
                    ka[k4] = *(const LAS bf16x8*)(lds + ML_KS + (16 * sb0 + fr) * ML_P + (32 * ks + 8 * fq) * 2);
                    kc[k4] = *(const LAS bf16x8*)(lds + ML_KS + (16 * (sb0 + 1) + fr) * ML_P + (32 * ks + 8 * fq) * 2); }
                SB1();
#pragma unroll
                for (int k4 = 0; k4 < 4; ++k4) { a0 = MFMA16(ka[k4], qa[k4], a0); a1 = MFMA16(kc[k4], qa[k4], a1); }
                SB1(); }
            const int t = 16 * tb + fr;
            { const int s0 = 16 * sb0 + 4 * fq; float v[4];
#pragma unroll
              for (int i = 0; i < 4; ++i) v[i] = (s0 + i <= t) ? a0[i] * ex2(d0[i] - mt) : 0.f;
              *(LAS v2u*)(lds + ML_SS + t * ML_SP + 2 * s0) = (v2u){pk2(v[0], v[1]), pk2(v[2], v[3])}; }
            { const int s0 = 16 * (sb0 + 1) + 4 * fq; float v[4];
#pragma unroll
              for (int i = 0; i < 4; ++i) v[i] = (two && s0 + i <= t) ? a1[i] * ex2(d1[i] - mt) : 0.f;
              *(LAS v2u*)(lds + ML_SS + t * ML_SP + 2 * s0) = (v2u){pk2(v[0], v[1]), pk2(v[2], v[3])}; }
          } else {
            const int t = 16 * tb + fr;
            *(LAS v2u*)(lds + ML_SS + t * ML_SP + 2 * (16 * sb0 + 4 * fq)) = (v2u){0u, 0u}; *(LAS v2u*)(lds + ML_SS + t * ML_SP + 2 * (16 * (sb0 + 1) + 4 * fq)) = (v2u){0u, 0u};
          } }
        __syncthreads();
        { const int tb = w & 3, half = w >> 2, t = 16 * tb + fr;
          bf16x8 qf[8], sf[2], ca[8], vx[2];
          f32x4 qc[3], sv[3];
#pragma unroll
          for (int ks = 0; ks < 8; ++ks) qf[ks] = *(const LAS bf16x8*)(lds + ML_QS + t * ML_P + (32 * ks + 8 * fq) * 2);
#pragma unroll
          for (int ks = 0; ks < 2; ++ks) sf[ks] = *(const LAS bf16x8*)(lds + ML_SS + t * ML_SP + (32 * ks + 8 * fq) * 2);
          const float wt_t = gwt[t], em_t = gem[t];
#pragma unroll
          for (int j = 0; j < 3; ++j) { const int vb = (j == 2) ? 4 : (2 * half + j);
#pragma unroll
              for (int ks = 0; ks < 8; ++ks) ca[ks] = *(const LAS bf16x8*)(lds + ML_CT + (16 * vb + fr) * ML_P + (32 * ks + 8 * fq) * 2);
#pragma unroll
              for (int ks = 0; ks < 2; ++ks) { const LAS unsigned char* p0 = lds + ML_VX + (32 * ks + 8 * fq + q4) * ML_VP + (16 * vb + 4 * p4) * 2; vx[ks] = tr8(p0, p0 + 4 * ML_VP); }
              SB2();
              f32x4 a = (f32x4){0.f, 0.f, 0.f, 0.f}, b2 = a;
#pragma unroll
              for (int ks = 0; ks < 2; ++ks) b2 = MFMA16(vx[ks], sf[ks], b2);
#pragma unroll
              for (int ks = 0; ks < 8; ++ks) a = MFMA16(ca[ks], qf[ks], a);
              qc[j] = a; sv[j] = b2;
              SB2(); }
          const float den = __shfl(wt_t * qc[2][0] + sv[2][0], fr);
          const float inv = __builtin_amdgcn_rcpf(fmaxf(fabsf(den), em_t));
#pragma unroll
          for (int j = 0; j < 2; ++j) { const int vb = 2 * half + j; float o[4];
#pragma unroll
              for (int i = 0; i < 4; ++i) o[i] = (wt_t * qc[j][i] + sv[j][i]) * inv;
              *(GAS v2u*)(hm + (size_t)(lrow0 + t0 + t) * 1024 + h * 256 + sl * 64 + 16 * vb + 4 * fq) = (v2u){pk2(o[0], o[1]), pk2(o[2], o[3])}; } }
        __syncthreads();
        if (c + 1 < L / 64) ML_LOAD_Q(t0 + 64);
        { bf16x8 kf[2][2], vf[5][2];
#pragma unroll
          for (int dbi = 0; dbi < 2; ++dbi)
#pragma unroll
            for (int ks = 0; ks < 2; ++ks) { const LAS unsigned char* p0 = lds + ML_KS + (32 * ks + 8 * fq + q4) * ML_P + (16 * (2 * w + dbi) + 4 * p4) * 2; kf[dbi][ks] = tr8(p0, p0 + 4 * ML_P); }
#pragma unroll
          for (int vb = 0; vb < 5; ++vb)
#pragma unroll
            for (int ks = 0; ks < 2; ++ks) { const LAS unsigned char* p0 = lds + ML_VW + (32 * ks + 8 * fq + q4) * ML_VP + (16 * vb + 4 * p4) * 2; vf[vb][ks] = tr8(p0, p0 + 4 * ML_VP); }
#pragma unroll
          for (int vb = 0; vb < 5; ++vb)
#pragma unroll
            for (int dbi = 0; dbi < 2; ++dbi) Cacc[vb][dbi] = Cacc[vb][dbi] * decay;
          SB3();
#pragma unroll
          for (int ks = 0; ks < 2; ++ks)
#pragma unroll
            for (int vb = 0; vb < 5; ++vb)
#pragma unroll
              for (int dbi = 0; dbi < 2; ++dbi) Cacc[vb][dbi] = MFMA16(kf[dbi][ks], vf[vb][ks], Cacc[vb][dbi]);
          SB3();
#pragma unroll
          for (int vb = 0; vb < 5; ++vb)
#pragma unroll
            for (int dbi = 0; dbi < 2; ++dbi) { const f32x4 a = Cacc[vb][dbi];
                *(LAS v2u*)(lds + ML_CT + (16 * vb + fr) * ML_P + (16 * (2 * w + dbi) + 4 * fq) * 2) = (v2u){pk2(a[0], a[1]), pk2(a[2], a[3])}; } }
        m_prev = g + M63;
        __syncthreads();
    }
#undef ML_LOAD_KV
#undef ML_LOAD_Q
}

constexpr int AT_KB = 0, AT_VB = 69632, AT_TBL = 139264, AT_KP = 272, AT_VP = 544, AT_KBUF = 17408, AT_VBUF = 34816, AT_XP = 1040;
DI void attn_item(Frame& F, int layer, int item) {
    const int qi = 31 - (item >> 4), r4 = item & 15, bl = r4 >> 2, h = r4 & 3;
    const int lrow0 = bl * L;
    const bf16* proj = (const bf16*)(F.ws + WS_PROJ); bf16* Y = (bf16*)(F.ws + WS_Y);
    LAS unsigned char* lds = F.lds; LAS float* tbl = (LAS float*)(lds + AT_TBL);
    const int tid = F.tid, lane = F.lane, w = F.wave, map = w >> 2, wq = w & 3, fr = lane & 15, fq = lane >> 4, q4 = fr >> 2, p4 = fr & 3;
    if (w >= 4) __builtin_amdgcn_s_setprio(1);
    if (tid < 128) tbl[tid] = ((const float*)(F.ws + T_BIAS))[h * 128 + tid];
    else if (tid < 384) tbl[tid] = F.in[10][layer * 1024 + h * 256 + tid - 128];
    const float lam_full = ((const float*)(F.ws + T_LAM))[2 * layer], post = ((const float*)(F.ws + T_LAM))[2 * layer + 1];
    const int r0 = 64 * qi + 16 * wq;
    bf16x8 qf[4];
    { const bf16* qp = proj + (size_t)(lrow0 + r0 + fr) * NP + C_QD + h * 256 + map * 128 + 8 * fq;
#pragma unroll
      for (int ks = 0; ks < 4; ++ks) qf[ks] = *(const GAS bf16x8*)(qp + 32 * ks); }
    const bf16* kbase = proj + (size_t)lrow0 * NP + C_KD + h * 256;
    const bf16* vbase = proj + (size_t)lrow0 * NP + C_VD + h * 256;
    const int nkt = qi + 1;
    f32x4 O[16];
#pragma unroll
    for (int i = 0; i < 16; ++i) O[i] = (f32x4){0.f, 0.f, 0.f, 0.f};
    float mrun = -INFINITY, lsum = 0.f;
    const float sc2 = 0.08838834764831845f * 1.4426950408889634f;
    v4u kreg[4], vreg[4];
#define AT_LOAD(kt) do { _Pragma("unroll") for (int i = 0; i < 4; ++i) { const int q = tid + NTHR * i, row = q >> 5, c16 = q & 31; kreg[i] = *(const GAS v4u*)(kbase + (size_t)(64 * (kt) + row) * NP + 8 * c16); } \
        _Pragma("unroll") for (int i = 0; i < 4; ++i) { const int q = tid + NTHR * i, row = q >> 5, c16 = q & 31; vreg[i] = *(const GAS v4u*)(vbase + (size_t)(64 * (kt) + row) * NP + 8 * c16); } } while (0)
#define AT_STORE(buf) do { _Pragma("unroll") for (int i = 0; i < 4; ++i) { const int q = tid + NTHR * i, row = q >> 5, c16 = q & 31; *(LAS v4u*)(lds + AT_KB + ((c16 >> 4) * 2 + (buf)) * AT_KBUF + row * AT_KP + 16 * (c16 & 15)) = kreg[i]; } \
        _Pragma("unroll") for (int i = 0; i < 4; ++i) { const int q = tid + NTHR * i, row = q >> 5, c16 = q & 31; *(LAS v4u*)(lds + AT_VB + (buf) * AT_VBUF + row * AT_VP + 16 * c16) = vreg[i]; } } while (0)
    AT_LOAD(0); AT_STORE(0);
    __syncthreads();
    for (int kt = 0; kt < nkt; ++kt) {
        const int buf = kt & 1, k0 = 64 * kt;
        if (kt + 1 < nkt) AT_LOAD(kt + 1);
        {
            const LAS unsigned char* kb_ = lds + AT_KB + (map * 2 + buf) * AT_KBUF; const LAS unsigned char* vb_ = lds + AT_VB + buf * AT_VBUF;
            f32x4 s[4];
            { bf16x8 kf[16];
#pragma unroll
              for (int kb = 0; kb < 4; ++kb)
#pragma unroll
                for (int ks = 0; ks < 4; ++ks) kf[4 * kb + ks] = *(const LAS bf16x8*)(kb_ + (16 * kb + fr) * AT_KP + (32 * ks + 8 * fq) * 2);
              SB();
#pragma unroll
              for (int kb = 0; kb < 4; ++kb) s[kb] = (f32x4){0.f, 0.f, 0.f, 0.f};
#pragma unroll
              for (int ks = 0; ks < 4; ++ks)
#pragma unroll
                for (int kb = 0; kb < 4; ++kb) s[kb] = MFMA16(kf[4 * kb + ks], qf[ks], s[kb]);
              SB(); }
            const int qpos = r0 + fr; const bool far = (r0 - (k0 + 63)) >= 113; const float bfar = tbl[127];
            float mx = -INFINITY;
            if (far) {
#pragma unroll
                for (int kb = 0; kb < 4; ++kb)
#pragma unroll
                    for (int i = 0; i < 4; ++i) { const float v = s[kb][i] * sc2 + bfar; s[kb][i] = v; mx = fmaxf(mx, v); }
            } else {
#pragma unroll
                for (int kb = 0; kb < 4; ++kb)
#pragma unroll
                    for (int i = 0; i < 4; ++i) { const int kpos = k0 + 16 * kb + 4 * fq + i, dist = qpos - kpos;
                        const float bias = tbl[dist < 0 ? 0 : (dist > 127 ? 127 : dist)];
                        float v = s[kb][i] * sc2 + bias; if (dist < 0) v = -INFINITY; s[kb][i] = v; mx = fmaxf(mx, v); }
            }
            mx = fmaxf(mx, __shfl_xor(mx, 16)); mx = fmaxf(mx, __shfl_xor(mx, 32));
            if (__any(mx > mrun + 11.5415603f)) {
                const float mnew = fmaxf(mrun, mx), alpha = ex2(mrun - mnew);
                mrun = mnew; lsum *= alpha;
#pragma unroll
                for (int i = 0; i < 16; ++i) O[i] = O[i] * alpha;
            }
            float ps = 0.f;
#pragma unroll
            for (int kb = 0; kb < 4; ++kb)
#pragma unroll
                for (int i = 0; i < 4; ++i) { const float p = ex2(s[kb][i] - mrun); s[kb][i] = p; ps += p; }
            lsum += ps;
            bf16x8 pb[2];
#pragma unroll
            for (int k2 = 0; k2 < 2; ++k2) { v4u t; t.x = pk2(s[2 * k2][0], s[2 * k2][1]); t.y = pk2(s[2 * k2][2], s[2 * k2][3]); t.z = pk2(s[2 * k2 + 1][0], s[2 * k2 + 1][1]); t.w = pk2(s[2 * k2 + 1][2], s[2 * k2 + 1][3]);
                pb[k2] = __builtin_bit_cast(bf16x8, t); }
            bf16x8 vfa[8], vfb[8];
#define AT_VLOAD(dst, b) do { _Pragma("unroll") for (int j = 0; j < 4; ++j) _Pragma("unroll") for (int k2 = 0; k2 < 2; ++k2) { \
                const LAS unsigned char* p0 = vb_ + (32 * k2 + 4 * fq + q4) * AT_VP + (16 * (4 * (b) + j) + 4 * p4) * 2; dst[2 * j + k2] = tr8(p0, p0 + 16 * AT_VP); } } while (0)
#define AT_VMMA(src, b) do { _Pragma("unroll") for (int j = 0; j < 4; ++j) _Pragma("unroll") for (int k2 = 0; k2 < 2; ++k2) O[4 * (b) + j] = MFMA16(src[2 * j + k2], pb[k2], O[4 * (b) + j]); } while (0)
            AT_VLOAD(vfa, 0); SB();
            AT_VLOAD(vfb, 1); SB(); AT_VMMA(vfa, 0); SB();
            AT_VLOAD(vfa, 2); SB(); AT_VMMA(vfb, 1); SB();
            AT_VLOAD(vfb, 3); SB(); AT_VMMA(vfa, 2); SB();
            AT_VMMA(vfb, 3); SB();
#undef AT_VLOAD
#undef AT_VMMA
        }
        if (kt + 1 < nkt) AT_STORE(buf ^ 1);
        __syncthreads();
    }
#undef AT_LOAD
#undef AT_STORE
    __builtin_amdgcn_s_setprio(0);
    lsum += __shfl_xor(lsum, 16); lsum += __shfl_xor(lsum, 32);
    const float inv = 1.0f / lsum;
    LAS unsigned char* xo = lds + (16 * wq + fr) * AT_XP + 16 * fq;
    if (map == 1) {
#pragma unroll
        for (int vb = 0; vb < 16; ++vb) *(LAS f32x4*)(xo + 64 * vb) = O[vb] * inv; }
    __syncthreads();
    if (map == 0) {
        float ss = 0.f;
#pragma unroll
        for (int vb = 0; vb < 16; ++vb) { const f32x4 o2 = *(const LAS f32x4*)(xo + 64 * vb); const f32x4 d = O[vb] * inv - o2 * lam_full; O[vb] = d;
            ss += (d.x * d.x + d.y * d.y) + (d.z * d.z + d.w * d.w); }
        ss += __shfl_xor(ss, 16); ss += __shfl_xor(ss, 32);
        const float rstd = post / sqrtf(ss * (1.0f / 256.0f) + EPS);
        const LAS float* gdn = tbl + 128 + 4 * fq;
        bf16* yp = Y + (size_t)MC * 1024 + (size_t)(lrow0 + r0 + fr) * 1024 + h * 256 + 4 * fq;
#pragma unroll
        for (int vb = 0; vb < 16; ++vb) { const f32x4 g = *(const LAS f32x4*)(gdn + 16 * vb); const f32x4 o = O[vb] * rstd * g;
            *(GAS v2u*)(yp + 16 * vb) = (v2u){pk2(o.x, o.y), pk2(o.z, o.w)}; }
    }
}

constexpr int S5_WB = 12800, S5_BUP = 528, S5_XO = 8448, S5_XP = 272;
DI void s5_item(Frame& F, int layer, int item) {
    const int bl = item >> 3, g = (item & 7) * 8 + F.wave, lrow0 = bl * L;
    const bf16* proj = (const bf16*)(F.ws + WS_PROJ); bf16* ys5 = (bf16*)(F.ws + WS_YS5);
    LAS unsigned char* bu = F.lds + F.wave * S5_WB; LAS unsigned char* xs = bu + S5_XO;
    const int lane = F.lane, fr = lane & 15, fq = lane >> 4;
    const int lg = layer * 64 + g;
    bf16x8 bbf[8], ctf[4];
    const bf16x8 zf = (bf16x8){0, 0, 0, 0, 0, 0, 0, 0};
#pragma unroll
    for (int nb = 0; nb < 8; ++nb) { bbf[nb] = zf; if (fq < 2) bbf[nb] = *(const GAS bf16x8*)((const bf16*)(F.ws + T_BBT) + ((size_t)lg * 128 + 16 * nb + fr) * 16 + 8 * fq); }
#pragma unroll
    for (int ks = 0; ks < 4; ++ks) ctf[ks] = *(const GAS bf16x8*)((const bf16*)(F.ws + T_CT) + ((size_t)lg * 16 + fr) * 128 + 32 * ks + 8 * fq);
    const float ar = ((const float*)(F.ws + T_S5A))[2 * (lg * 64 + lane)], ai = ((const float*)(F.ws + T_S5A))[2 * (lg * 64 + lane) + 1];
    const float dsk = F.in[19][layer * 1024 + g * 16 + fr];
    bf16x8 dskf = zf;
#pragma unroll
    for (int j = 0; j < 8; ++j) if (fq < 2 && 8 * fq + j == fr) dskf[j] = (short)f2bf(dsk);
    float xr = 0.f, xi = 0.f;
    const bf16* up = proj + (size_t)lrow0 * NP + C_US + g * 16;
    bf16x8 ac[4], an[4];
#pragma unroll
    for (int k = 0; k < 4; ++k) { ac[k] = zf; an[k] = zf; if (fq < 2) ac[k] = *(const GAS bf16x8*)(up + (size_t)(16 * k + fr) * NP + 8 * fq); }
    for (int blk = 0; blk < L / 64; ++blk) {
        if (blk + 1 < L / 64) {
#pragma unroll
            for (int k = 0; k < 4; ++k) if (fq < 2) an[k] = *(const GAS bf16x8*)(up + (size_t)(64 * (blk + 1) + 16 * k + fr) * NP + 8 * fq); }
#pragma unroll
        for (int k = 0; k < 4; ++k) {
            const int t0 = 64 * blk + 16 * k; const bf16x8 a = ac[k];
#pragma unroll
            for (int nb = 0; nb < 8; ++nb) { const f32x4 acc = MFMA16(bbf[nb], a, ((f32x4){0.f, 0.f, 0.f, 0.f}));
                *(LAS f32x4*)(bu + fr * S5_BUP + 4 * (16 * nb + 4 * fq)) = acc; }
            LDS_WAIT();
            f32x2 b2[16];
#pragma unroll
            for (int t = 0; t < 16; ++t) b2[t] = *(const LAS f32x2*)(bu + t * S5_BUP + 8 * lane);
#pragma unroll
            for (int t = 0; t < 16; ++t) { const float nr = ar * xr - ai * xi + b2[t].x, ni = ar * xi + ai * xr + b2[t].y; xr = nr; xi = ni;
                *(LAS unsigned*)(xs + t * S5_XP + 4 * lane) = pk2(xr, xi); }
            LDS_WAIT();
            bf16x8 xa[4];
#pragma unroll
            for (int ks = 0; ks < 4; ++ks) xa[ks] = *(const LAS bf16x8*)(xs + fr * S5_XP + (32 * ks + 8 * fq) * 2);
            f32x4 y = MFMA16(dskf, a, ((f32x4){0.f, 0.f, 0.f, 0.f}));
#pragma unroll
            for (int ks = 0; ks < 4; ++ks) y = MFMA16(ctf[ks], xa[ks], y);
            *(GAS v2u*)(ys5 + (size_t)(lrow0 + t0 + fr) * 1024 + g * 16 + 4 * fq) = (v2u){pk2(gelu_tanh(y[0]), gelu_tanh(y[1])), pk2(gelu_tanh(y[2]), gelu_tanh(y[3]))};
            LDS_WAIT();
        }
#pragma unroll
        for (int k = 0; k < 4; ++k) ac[k] = an[k];
    }
}

DI void p4_post_norms(Frame& F, int layer) {
    const bf16* proj = (const bf16*)(F.ws + WS_PROJ); const bf16* hm = (const bf16*)(F.ws + WS_HM);
    bf16* Y = (bf16*)(F.ws + WS_Y);
    const int lane = F.lane;
    const float* gm = F.in[8] + layer * 1024;
    const int gw = F.bid * NWAVES + F.wave, NGW = F.G * NWAVES;
    for (int r = gw; r < MC; r += NGW) {
#pragma unroll
        for (int h = 0; h < 4; ++h) { const int c = h * 256 + 4 * lane;
            const v2u hv = *(const GAS v2u*)(hm + (size_t)r * 1024 + c), ov = *(const GAS v2u*)(proj + (size_t)r * NP + C_OM + c);
            const float v0 = bflo(hv.x), v1 = bfhi(hv.x), v2 = bflo(hv.y), v3 = bfhi(hv.y);
            const float rstd = 1.0f / sqrtf(wave_sum(v0 * v0 + v1 * v1 + v2 * v2 + v3 * v3) * (1.0f / 256.0f) + EPS);
            const f32x4 gg = *(const GAS f32x4*)(gm + c);
            v2u o; o.x = pk2(sigm(bflo(ov.x)) * v0 * rstd * gg.x, sigm(bfhi(ov.x)) * v1 * rstd * gg.y); o.y = pk2(sigm(bflo(ov.y)) * v2 * rstd * gg.z, sigm(bfhi(ov.y)) * v3 * rstd * gg.w);
            *(GAS v2u*)(Y + (size_t)r * 1024 + c) = o; }
    }
}

#ifndef RES_NO_NT
#define PR_ST(p_, v_) __builtin_nontemporal_store((v_), (p_))
#else
#define PR_ST(p_, v_) (*(p_) = (v_))
#endif
#ifndef RES_NO_NT_LD
#define PR_LD(p_) __builtin_nontemporal_load(p_)
#else
#define PR_LD(p_) (*(p_))
#endif
template <bool XIN_F32, bool XOUT_F32, int XN_I8 = 0>
DI void p_residual(Frame& F, int nrows, const bf16* ysrc, const void* xsrc_, void* out_, bf16* xn, const float* gpost, const float* gnext, float* sa = nullptr, unsigned char* xn8 = nullptr) {
    const int lane = F.lane, gw = F.bid * NWAVES + F.wave, NGW = F.G * NWAVES;
    const float* xsrc32 = (const float*)xsrc_; const bf16* xsrc16 = (const bf16*)xsrc_; float* out32 = (float*)out_; bf16* out16 = (bf16*)out_;
    f32x4 gp[8], gn[8];
#pragma unroll
    for (int j = 0; j < 8; ++j) { const int c = 4 * (lane + 64 * j); gp[j] = *(const GAS f32x4*)(gpost + c); gn[j] = gnext ? *(const GAS f32x4*)(gnext + c) : (f32x4){0.f, 0.f, 0.f, 0.f}; }
    constexpr bool DEEP = !XIN_F32;
    v2u yw[8], ywn[8], ywn2[DEEP ? 8 : 1]; f32x4 xv[XIN_F32 ? 8 : 1], xvn[XIN_F32 ? 8 : 1]; v2u xw[XIN_F32 ? 1 : 8], xwn[XIN_F32 ? 1 : 8], xwn2[XIN_F32 ? 1 : 8];
#define PR_LOAD(r_, YW, XV, XW) do { _Pragma("unroll") for (int j = 0; j < 8; ++j) { YW[j] = PR_LD((const GAS v2u*)(ysrc + (size_t)(r_) * D + 4 * (lane + 64 * j))); \
        if constexpr (XIN_F32) XV[j] = PR_LD((const GAS f32x4*)(xsrc32 + (size_t)(r_) * D + 4 * (lane + 64 * j))); \
        else XW[j] = PR_LD((const GAS v2u*)(xsrc16 + (size_t)(r_) * D + 4 * (lane + 64 * j))); } } while (0)
    if (gw < nrows) PR_LOAD(gw, yw, xv, xw);
    if constexpr (DEEP) { if (gw + NGW < nrows) PR_LOAD(gw + NGW, ywn, xvn, xwn); }
    for (int r = gw; r < nrows; r += NGW) { const size_t grow = (size_t)r;
        if constexpr (DEEP) { if (r + 2 * NGW < nrows) PR_LOAD(r + 2 * NGW, ywn2, xvn, xwn2); }
        else { if (r + NGW < nrows) PR_LOAD(r + NGW, ywn, xvn, xwn); }
        f32x4 y[8]; float s = 0.f;
#pragma unroll
        for (int j = 0; j < 8; ++j) { y[j] = (f32x4){bflo(yw[j].x), bfhi(yw[j].x), bflo(yw[j].y), bfhi(yw[j].y)}; s += (y[j].x * y[j].x + y[j].y * y[j].y) + (y[j].z * y[j].z + y[j].w * y[j].w); }
        const float rstd = 1.0f / sqrtf(wave_sum(s) * (1.0f / D) + EPS);
        float s2 = 0.f;
#pragma unroll
        for (int j = 0; j < 8; ++j) { f32x4 xin; if constexpr (XIN_F32) xin = xv[j]; else xin = (f32x4){bflo(xw[j].x), bfhi(xw[j].x), bflo(xw[j].y), bfhi(xw[j].y)};
            const f32x4 o = xin + y[j] * rstd * gp[j];
            if (XOUT_F32) PR_ST((GAS f32x4*)(out32 + grow * D + 4 * (lane + 64 * j)), o);
            else PR_ST((GAS v2u*)(out16 + grow * D + 4 * (lane + 64 * j)), ((v2u){pk2(o.x, o.y), pk2(o.z, o.w)}));
            y[j] = o;
            s2 += (o.x * o.x + o.y * o.y) + (o.z * o.z + o.w * o.w); }
        if (gnext) { const float rstd2 = 1.0f / sqrtf(wave_sum(s2) * (1.0f / D) + EPS);
#pragma unroll
            for (int j = 0; j < 8; ++j) y[j] = y[j] * rstd2 * gn[j];
            if (XN_I8) { float mx = 0.f; unsigned char* o8 = XN_I8 == 2 ? xn8 : (unsigned char*)xn;
#pragma unroll
                for (int j = 0; j < 8; ++j) mx = fmaxf(fmaxf(mx, fmaxf(fabsf(y[j].x), fabsf(y[j].y))), fmaxf(fabsf(y[j].z), fabsf(y[j].w)));
                mx = wave_max(mx); const float inv = mx > 0.f ? 127.0f / mx : 0.f;
#pragma unroll
                for (int j = 0; j < 8; ++j) PR_ST((GAS unsigned*)(o8 + grow * D + 4 * (lane + 64 * j)), pack_i8(y[j], inv));
                if (lane == 0) sa[grow] = mx * (1.0f / 127.0f);
            }
            if (XN_I8 != 1) {
#pragma unroll
                for (int j = 0; j < 8; ++j) { const f32x4 o = y[j];
                    PR_ST((GAS v2u*)(xn + grow * D + 4 * (lane + 64 * j)), ((v2u){pk2(o.x, o.y), pk2(o.z, o.w)})); } } }
#pragma unroll
        for (int j = 0; j < 8; ++j) { yw[j] = ywn[j]; if constexpr (XIN_F32) xv[j] = xvn[j]; else { xw[j] = xwn[j]; xwn[j] = xwn2[j]; ywn[j] = ywn2[j]; } }
    }
#undef PR_LOAD
}

DI void p9_fixup(Frame& F, int layer) {
    const bf16* raw = (const bf16*)(F.ws + WS_RAW); bf16* act = (bf16*)(F.ws + WS_ACT);

    const float* cw = F.in[24] + (size_t)layer * 3 * NUP; const float* cb = F.in[25] + (size_t)layer * NUP;
    const int gt = F.bid * NTHR + F.tid, NGT = F.G * NTHR;
    constexpr int NCG = DFF / 8;
    for (int task = gt; task < NCG * (MH / 64); task += NGT) {
        const int cg = task % NCG, blk = task / NCG, c = 8 * cg, t0 = (blk * 64) & (L - 1);
        const bf16* rb = raw + (size_t)blk * 4 * 2 * DFF + c;
        const bf16* rp = rb - (size_t)4 * 2 * DFF;
        v4u xa[4], xv[4];
#pragma unroll
        for (int k = 0; k < 2; ++k) { xa[k] = (v4u){0u, 0u, 0u, 0u}; xv[k] = xa[k];
            if (t0 > 0) { xa[k] = *(const GAS v4u*)(rp + (size_t)(2 + k) * 2 * DFF); xv[k] = *(const GAS v4u*)(rp + (size_t)(2 + k) * 2 * DFF + DFF); }
            xa[2 + k] = *(const GAS v4u*)(rb + (size_t)k * 2 * DFF); xv[2 + k] = *(const GAS v4u*)(rb + (size_t)k * 2 * DFF + DFF); }
#pragma unroll
        for (int r = 0; r < 2; ++r) {
            unsigned o[4];
#pragma unroll
            for (int k = 0; k < 4; ++k) { float res[2];
#pragma unroll
                for (int hh = 0; hh < 2; ++hh) { const int cc = c + 2 * k + hh;
                    const float a0 = hh ? bfhi(xa[r][k]) : bflo(xa[r][k]), a1 = hh ? bfhi(xa[r + 1][k]) : bflo(xa[r + 1][k]), a2 = hh ? bfhi(xa[r + 2][k]) : bflo(xa[r + 2][k]);
                    const float v0 = hh ? bfhi(xv[r][k]) : bflo(xv[r][k]), v1 = hh ? bfhi(xv[r + 1][k]) : bflo(xv[r + 1][k]), v2 = hh ? bfhi(xv[r + 2][k]) : bflo(xv[r + 2][k]);
                    const float ya = cw[cc] * a0 + cw[NUP + cc] * a1 + cw[2 * NUP + cc] * a2 + cb[cc];
                    const float yv = cw[DFF + cc] * v0 + cw[NUP + DFF + cc] * v1 + cw[2 * NUP + DFF + cc] * v2 + cb[DFF + cc];
                    res[hh] = gelu_tanh(ya) * yv; }
                o[k] = pk2(res[0], res[1]); }
            *(GAS v4u*)(act + (size_t)(blk * 64 + r) * DFF + c) = (v4u){o[0], o[1], o[2], o[3]};
        }
    }
}
#define XB_TMO      128
#define XB_XCNT(j)  (256  + 64 * (j))
#define XB_XSUB(j)  (1280 + 64 * (j))
#define XB_XGEN(j)  (2304 + 64 * (j))
#define XB_TOP      3328
#define XB_TOPGEN   3392
#define XCD_BAR_WORDS 3456
#define XB_SPIN_CAP (1u << 18)

__device__ __forceinline__ unsigned xb_ld(unsigned* p)              { return __hip_atomic_load(p, __ATOMIC_RELAXED, __HIP_MEMORY_SCOPE_AGENT); }
__device__ __forceinline__ unsigned xb_add(unsigned* p, unsigned v) { return __hip_atomic_fetch_add(p, v, __ATOMIC_RELAXED, __HIP_MEMORY_SCOPE_AGENT); }
__device__ __forceinline__ unsigned xb_xcc_id() { return (unsigned)__builtin_amdgcn_s_getreg((3 << 11) | 20) & 0xFu; }
#define XB_SPIN(cond, bar) do { unsigned _sp = 0; while (cond) { __builtin_amdgcn_s_sleep(1); \
    if ((++_sp & 255u) == 0u) { if (xb_ld(&(bar)[XB_TMO])) break; if (_sp > XB_SPIN_CAP) { atomicAdd(&(bar)[XB_TMO], 1u); break; } } } } while (0)

struct XcdBarrier {
    unsigned* bar; unsigned x;
    volatile LAS unsigned* st;
};

__device__ __forceinline__ XcdBarrier xcd_barrier_post(unsigned* bar, volatile LAS unsigned* st) {
    XcdBarrier b; b.bar = bar; b.x = xb_xcc_id(); b.st = st;
    if (threadIdx.x == 0) (void)xb_add(&bar[XB_XCNT(b.x)], 1u);
    return b;
}
__device__ __forceinline__ void xcd_barrier_complete(unsigned* bar, unsigned x, unsigned& nloc, unsigned& nx) {
    const unsigned G = gridDim.x * gridDim.y * gridDim.z;
    unsigned sum, cnt, mine, sp = 0u;
    for (;;) {
        sum = 0u; cnt = 0u; mine = 0u;
#pragma unroll
        for (unsigned j = 0; j < 16; ++j) { const unsigned c = xb_ld(&bar[XB_XCNT(j)]); sum += c; cnt += (c > 0u) ? 1u : 0u; mine = (j == x) ? c : mine; }
        if (sum == G) break;
        __builtin_amdgcn_s_sleep(1);
        if ((++sp & 255u) == 0u) { if (xb_ld(&bar[XB_TMO])) break; if (sp > XB_SPIN_CAP) { atomicAdd(&bar[XB_TMO], 1u); break; } }
    }
    nloc = mine > 0u ? mine : 1u; nx = cnt > 0u ? cnt : 1u;
}

__device__ __forceinline__ void xcd_barrier(const XcdBarrier& b) {
    asm volatile("s_waitcnt vmcnt(0)" ::: "memory");
    __syncthreads();
    if (threadIdx.x == 0) {
        unsigned* bar = b.bar;
        __builtin_amdgcn_s_waitcnt(0);
        unsigned nloc = b.st[0], nx = b.st[1];
        if (nloc == 0u) { xcd_barrier_complete(bar, b.x, nloc, nx); b.st[0] = nloc; b.st[1] = nx; }
        const unsigned old = xb_add(&bar[XB_XSUB(b.x)], 1u);
        const unsigned gen = old / nloc;
        if (old + 1u == (gen + 1u) * nloc) {
            __builtin_amdgcn_fence(__ATOMIC_RELEASE, "agent");
            asm volatile("s_waitcnt vmcnt(0)" ::: "memory");
            const unsigned og = xb_add(&bar[XB_TOP], 1u);
            const unsigned tg = og / nx;
            if (og + 1u == (tg + 1u) * nx) xb_add(&bar[XB_TOPGEN], 1u);
            else XB_SPIN(xb_ld(&bar[XB_TOPGEN]) == tg, bar);
            __builtin_amdgcn_fence(__ATOMIC_ACQUIRE, "agent");
            xb_add(&bar[XB_XGEN(b.x)], 1u);
            asm volatile("s_waitcnt vmcnt(0)" ::: "memory");
        } else {
            XB_SPIN(xb_ld(&bar[XB_XGEN(b.x)]) == gen, bar);
            __builtin_amdgcn_fence(__ATOMIC_ACQUIRE, "agent");
            asm volatile("s_waitcnt vmcnt(0)" ::: "memory");
        }
    }
    __syncthreads();
}

struct Args { const float* in[27]; float* out; unsigned char* ws; int lc_lo, lc_hi, ph_lo, ph_hi, use_bar, pad; };
constexpr int N_ITEMS_ML = 64, N_ITEMS_S5 = 32, N_ITEMS_AT = 512, N_ITEMS = N_ITEMS_ML + N_ITEMS_S5 + N_ITEMS_AT;

__global__ void __launch_bounds__(NTHR, 2) fwd_kernel(Args args) {
    extern __shared__ __attribute__((aligned(16))) unsigned char lds_raw[];
    Frame F;
    F.lds = (LAS unsigned char*)lds_raw;
    F.MISC = (volatile LAS unsigned*)(F.lds + LDSCTL_OFF);
    F.tid = threadIdx.x; F.lane = F.tid & 63; F.wave = __builtin_amdgcn_readfirstlane(F.tid >> 6);
    F.G = gridDim.x; F.bid = blockIdx.x;
    F.ws = args.ws; F.ctl = (gu32*)(args.ws + WS_CTL); F.out = args.out;
    F.in = args.in;
    for (int u = F.tid; u < (LDS_BYTES - LDSCTL_OFF) / 4; u += NTHR) ((LAS unsigned*)(F.lds + LDSCTL_OFF))[u] = 0u;
    __syncthreads();
    XcdBarrier bar; bar.bar = (unsigned*)(F.ctl + CW_BAR); bar.x = 0; bar.st = nullptr;
    if (args.use_bar) bar = xcd_barrier_post((unsigned*)(F.ctl + CW_BAR), F.MISC + 8);
#ifdef DBG_DOUBLE_BAR
#define GRID_BAR() do { if (args.use_bar) { xcd_barrier(bar); xcd_barrier(bar); } } while (0)
#else
#define GRID_BAR() do { if (args.use_bar) { unsigned* b_ = (unsigned*)(args.ws + WS_CTL) + CW_BAR; asm volatile("" : "+s"(b_)); bar.bar = b_; xcd_barrier(bar); } } while (0)
#endif
    const int lo = args.ph_lo, hi = args.ph_hi;
#ifndef PH_MASK
#define PH_MASK 0xFFF
#endif
#ifndef GEMM_ALIGN
#define GEMM_ALIGN true
#endif
#ifndef GEMM_SP2
#define GEMM_SP2 true
#endif
#ifndef DBG_REPEAT
#define DBG_REPEAT -1
#endif
#ifndef DBG_STORE_MOD
#define DBG_STORE_MOD 1000000
#endif
#define REP(k) ((k) == DBG_REPEAT ? 2 : 1)
#define IN(k) (((PH_MASK >> (k)) & 1) && lo <= (k) && (k) < hi)
#define RELAUNDER() do { int t_ = threadIdx.x; asm volatile("" : "+v"(t_)); F.tid = t_; F.lane = t_ & 63; F.wave = __builtin_amdgcn_readfirstlane(t_ >> 6); \
        unsigned char* w_ = args.ws; asm volatile("" : "+s"(w_)); F.ws = w_; F.ctl = (gu32*)(w_ + WS_CTL); float* o_ = args.out; asm volatile("" : "+s"(o_)); F.out = o_; } while (0)

    for (int layer = 0; layer < DEPTH; ++layer) {
        for (int rep = 0; rep < REP(0); ++rep) if (IN(0)) { RELAUNDER(); p0_weights(F, layer); if (layer == 0) p0_tables(F); __syncthreads(); GRID_BAR(); }

        for (int chunk = 0; chunk < NCH; ++chunk) {
            const int lc = layer * NCH + chunk;
            for (int rep = 0; rep < REP(1); ++rep) if (IN(1)) { RELAUNDER();
                { pg8::Gemm g{(const bf16*)(F.ws + WS_XN) + (size_t)chunk * MC * D, (const bf16*)(F.ws + WS_WIN), MC, 4096, D, nullptr};
                  pg8::StaticOrder S; S.init(MC, 4096, F.G, F.bid);
                  pg8::EpiBf16 E{(bf16*)(F.ws + WS_PROJ), NP, 0, 1 << 30, 8, 2048};
                  pg8::gemm_phase<pg8::EpiBf16, pg8::StaticOrder, GEMM_ALIGN, GEMM_SP2>(F.lds, g, S, E); }
                RELAUNDER();
                { pg8::Gemm g{(const bf16*)(F.ws + WS_XN8M + (size_t)chunk * MC * D), (const bf16*)(F.ws + WS_WG8), MC, NI8, D, nullptr};
                  pg8::StaticOrder S; S.init(MC, NI8, F.G, F.bid);
                  pg8::EpiGateI8 E{(bf16*)(F.ws + WS_PROJ), NP, C_GATE, (const float*)(F.ws + T_SA_MIX) + (size_t)chunk * MC, (const float*)(F.ws + T_SB_G)};
                  pg8::gemm_phase<pg8::EpiGateI8, pg8::StaticOrder, GEMM_ALIGN, GEMM_SP2, true>(F.lds, g, S, E); }
                GRID_BAR();
            }
            for (int rep = 0; rep < REP(2); ++rep) if (IN(2)) { RELAUNDER(); p2_conv_gates(F, layer, chunk); GRID_BAR(); }

            for (int rep3 = 0; rep3 < REP(3); ++rep3) if (IN(3)) {
                for (;;) { RELAUNDER();
                    const int xq = F.bid & 7;
                    if (F.tid == 0) F.MISC[0] = __hip_atomic_fetch_add(F.ctl + CW_QUEUE + 64 * (lc + 8 * rep3) + 8 * xq, 1u, RLX_AGENT);
                    __syncthreads();
                    const int qpos = __builtin_amdgcn_readfirstlane((int)F.MISC[0]);
                    __syncthreads();
                    if (qpos >= N_ITEMS / 8) break;
                    int item;
                    if (qpos < N_ITEMS_ML / 8) item = (N_ITEMS_ML / 8) * xq + qpos;
                    else if (qpos < (N_ITEMS_ML + N_ITEMS_S5) / 8) item = N_ITEMS_ML + (N_ITEMS_S5 / 8) * xq + (qpos - N_ITEMS_ML / 8);
                    else { const int a = qpos - (N_ITEMS_ML + N_ITEMS_S5) / 8; item = N_ITEMS_ML + N_ITEMS_S5 + ((a >> 1) << 4) + 2 * xq + (a & 1); }
#ifndef IT_MASK
#define IT_MASK 7
#endif
#ifndef DBG_REP_ITEMS
#define DBG_REP_ITEMS 7
#endif
                    const int itm = rep3 ? (IT_MASK & DBG_REP_ITEMS) : IT_MASK;
                    if (item < N_ITEMS_ML) { if (itm & 1) mlstm_item(F, chunk, item); }
                    else if (item < N_ITEMS_ML + N_ITEMS_S5) { if (itm & 2) s5_item(F, layer, item - N_ITEMS_ML); }
                    else { if (itm & 4) attn_item(F, layer, item - N_ITEMS_ML - N_ITEMS_S5); }
                    __syncthreads();
                }
                GRID_BAR();
            }
            for (int rep = 0; rep < REP(4); ++rep) if (IN(4)) { RELAUNDER();
                pg8::Gemm g{(const bf16*)(F.ws + WS_YS5), (const bf16*)(F.ws + WS_WGLU), MC, 2048, 1024, nullptr};
                pg8::StaticOrder S; S.init(MC, 2048, F.G, F.bid);
                pg8::EpiGlu E{(bf16*)(F.ws + WS_Y) + (size_t)2 * MC * 1024, 1024};
                pg8::gemm_phase<pg8::EpiGlu, pg8::StaticOrder, true, GEMM_SP2>(F.lds, g, S, E);
                p4_post_norms(F, layer);
                GRID_BAR();
            }
            for (int rep = 0; rep < REP(5); ++rep) if (IN(5)) { RELAUNDER();
                pg8::Gemm g{(const bf16*)(F.ws + WS_Y), (const bf16*)(F.ws + WS_WB), 3 * MC, 3 * 2048, 1024, nullptr};
                pg8::BranchOrder S; S.init(F.G, F.bid);
                pg8::EpiBranch E{(const bf16*)(F.ws + WS_PROJ), NP, C_GATE, (bf16*)(F.ws + WS_MERGED) + (size_t)chunk * MC * D, (const bf16*)(F.ws + T_ONES)};
                pg8::gemm_phase<pg8::EpiBranch, pg8::BranchOrder, true, GEMM_SP2>(F.lds, g, S, E);
                GRID_BAR();
            }
        }
        for (int rep = 0; rep < REP(6); ++rep) if (IN(6)) { RELAUNDER();
            pg8::Gemm g{(const bf16*)(F.ws + WS_MERGED), (const bf16*)(F.ws + WS_WOUT), M, D, D, nullptr};
            pg8::StaticOrder S; S.init(M, D, F.G, F.bid);
            pg8::EpiBf16 E{(bf16*)(F.ws + WS_MIX), D, 0, 1 << 30, 1 << 30, 0};
            pg8::gemm_phase<pg8::EpiBf16, pg8::StaticOrder, GEMM_ALIGN, GEMM_SP2>(F.lds, g, S, E);
            GRID_BAR();
        }
        for (int rep = 0; rep < (layer == 0 ? REP(7) : 1); ++rep) if (IN(7)) { RELAUNDER();
            if (layer == 0) p_residual<true, false, 1>(F, M, (const bf16*)(F.ws + WS_MIX), F.in[0], F.ws + WS_XB, (bf16*)(F.ws + WS_XN8F), F.in[2] + layer * D, F.in[3] + layer * D, (float*)(F.ws + T_SA_FFN));
            else p_residual<false, false, 1>(F, M, (const bf16*)(F.ws + WS_MIX), F.ws + WS_XB, F.ws + WS_XB, (bf16*)(F.ws + WS_XN8F), F.in[2] + layer * D, F.in[3] + layer * D, (float*)(F.ws + T_SA_FFN));
            GRID_BAR();
        }
        for (int half = 0; half < M / MH; ++half) {
            for (int rep = 0; rep < REP(8); ++rep) if (IN(8)) { RELAUNDER();
                pg8::Gemm g{(const bf16*)(F.ws + WS_XN8F + (size_t)half * MH * D), (const bf16*)(F.ws + WS_WUP), MH, NUP, D, nullptr};
                pg8::GemmOrder S; S.init(MH, NUP, F.G, F.bid, D / 64);
                pg8::EpiUpConv<true> E{(bf16*)(F.ws + WS_ACT), (bf16*)(F.ws + WS_RAW), F.in[24] + (size_t)layer * 3 * NUP, F.in[25] + (size_t)layer * NUP, DFF, NUP, (const float*)(F.ws + T_SA_FFN) + (size_t)half * MH, (const float*)(F.ws + T_SB_UP)
                };
                pg8::gemm_phase<pg8::EpiUpConv<true>, pg8::GemmOrder, GEMM_ALIGN, GEMM_SP2, true>(F.lds, g, S, E);
                GRID_BAR();
            }
            for (int rep = 0; rep < REP(9); ++rep) if (IN(9)) { RELAUNDER(); p9_fixup(F, layer); GRID_BAR(); }
            for (int rep = 0; rep < REP(10); ++rep) if (IN(10)) { RELAUNDER();
                pg8::Gemm g{(const bf16*)(F.ws + WS_ACT), (const bf16*)(F.ws + WS_WDN), MH, D, DFF, nullptr};
                pg8::StaticOrder S; S.init(MH, D, F.G, F.bid);
                pg8::EpiBf16 E{(bf16*)(F.ws + WS_FFN), D, 0, 1 << 30, 1 << 30, 0};
                pg8::gemm_phase<pg8::EpiBf16, pg8::StaticOrder, GEMM_ALIGN, GEMM_SP2>(F.lds, g, S, E);
                GRID_BAR();
            }
            if (IN(11)) { RELAUNDER();
                const size_t ro = (size_t)half * MH * D;
                if (layer + 1 < DEPTH) p_residual<false, false, 2>(F, MH, (const bf16*)(F.ws + WS_FFN), (const bf16*)(F.ws + WS_XB) + ro, (bf16*)(F.ws + WS_XB) + ro, (bf16*)(F.ws + WS_XN) + ro, F.in[4] + layer * D, F.in[1] + (layer + 1) * D,
                                                                      (float*)(F.ws + T_SA_MIX) + (size_t)half * MH, F.ws + WS_XN8M + ro);
                else p_residual<false, true>(F, MH, (const bf16*)(F.ws + WS_FFN), (const bf16*)(F.ws + WS_XB) + ro, F.out + ro, nullptr, F.in[4] + layer * D, nullptr);
                GRID_BAR();
            }
        }
    }
#undef IN
#undef GRID_BAR
}


#ifdef DBG_DUMP
__global__ void dbg_dump(const unsigned char* ws, float* out, size_t off, size_t nelem, int is_f32) {
    for (size_t i = (size_t)blockIdx.x * blockDim.x + threadIdx.x; i < (size_t)M * D; i += (size_t)gridDim.x * blockDim.x) {
        const size_t j = i % nelem; out[i] = is_f32 ? ((const float*)(ws + off))[j] : __uint_as_float(((unsigned)((const unsigned short*)(ws + off))[j]) << 16); }
}
#endif

#ifndef MK_SINGLE
#define MK_SINGLE 1
#endif
extern "C" void kernel_launch(void* const* d_in, const int* in_sizes, int n_in, void* d_out, int out_size, void* d_ws, size_t ws_size, hipStream_t stream) {
    static int grid = 0;
    if (grid == 0) {
        if (n_in != 27 || in_sizes[0] != M * D || out_size != M * D || ws_size < WS_END) { fprintf(stderr, "kernel_launch: unexpected shapes (n_in %d, in0 %d, out %d, ws %zu)\n", n_in, n_in > 0 ? in_sizes[0] : -1, out_size, ws_size); grid = -1; return; }
        int dev = 0, cus = 0, per_cu = 0;
        if (hipGetDevice(&dev) != hipSuccess || hipDeviceGetAttribute(&cus, hipDeviceAttributeMultiprocessorCount, dev) != hipSuccess) { grid = -1; return; }
        if (hipFuncSetAttribute((const void*)fwd_kernel, hipFuncAttributeMaxDynamicSharedMemorySize, LDS_BYTES) != hipSuccess) { grid = -1; return; }
        if (hipOccupancyMaxActiveBlocksPerMultiprocessor(&per_cu, (const void*)fwd_kernel, NTHR, LDS_BYTES) != hipSuccess || per_cu < 1) { fprintf(stderr, "kernel_launch: occupancy query says %d\n", per_cu); }
        (void)hipGetLastError();
        grid = cus;
    }
    if (grid < 0) return;
    if (hipMemsetAsync((char*)d_ws + WS_CTL, 0, CTL_ZERO_BYTES, stream) != hipSuccess) return;
    Args a{};
    for (int i = 0; i < 27; ++i) a.in[i] = (const float*)d_in[i];
    a.out = (float*)d_out; a.ws = (unsigned char*)d_ws; a.pad = 0;
    a.lc_lo = 0; a.lc_hi = DEPTH * NCH; a.ph_lo = 0; a.ph_hi = 12; a.use_bar = 1;
    hipLaunchKernelGGL(fwd_kernel, dim3(grid), dim3(NTHR), LDS_BYTES, stream, a);
}
```

```cpp
#include <hip/hip_runtime.h>
#include <cstdio>
#include <cstdint>
namespace pg8 {
#define PG8_LAS __attribute__((address_space(3)))
typedef unsigned short bf16_t;
typedef short bf16x8 __attribute__((ext_vector_type(8)));
typedef float f32x4 __attribute__((ext_vector_type(4)));
typedef unsigned u32x4 __attribute__((ext_vector_type(4)));
constexpr int BM = 256, BK = 64, HALF = 128, HTB = HALF * BK * 2  , STAGE_BYTES = 8 * HTB, NXCD = 8, WGM = 8;

__host__ __device__ __forceinline__ int lds_byte(int r, int c) { const int st = (r >> 4) * 2 + (c >> 5), rr = r & 15, cc = c & 31, ob = rr * 64 + cc * 2; return st * 1024 + (ob ^ (((ob >> 9) & 1) << 5)); }
__host__ __device__ __forceinline__ void stage_rc(int b, int& R, int& C) { const int st = b / 1024, sb = b % 1024, swz = sb ^ (((sb >> 9) & 1) << 5); R = (st >> 1) * 16 + swz / 64; C = (st & 1) * 32 + (swz % 64) / 2; }
__host__ __device__ __forceinline__ int perm32(int rho) { const int n = rho >> 4, i = rho & 15; return 8 * (i >> 2) + 4 * n + (i & 3); }

struct Unit { int pm, pn; int kb, nk, part; int st; };
struct Gemm { const bf16_t* A; const bf16_t* Bt; int M, N, K; float* pbuf; };

struct StaticOrder {
    static constexpr bool HAS_PARK = false, HAS_MID = false;
    int nM, nN, nwg, G, c;
    __host__ __device__ void init(int M, int N, int G_, int c_) { nM = M / BM; nN = N / BM; nwg = nM * nN; G = G_; c = c_; }
    __host__ __device__ bool next(int i, Unit& u) const {
        const long L = (long)i * G + c; if (L >= nwg) return false;
        int wgid = (int)L; { const int q = nwg / NXCD, r = nwg % NXCD, xcd = wgid % NXCD, off = wgid / NXCD; wgid = (xcd < r ? xcd * (q + 1) : r * (q + 1) + (xcd - r) * q) + off; }
        const int nig = WGM * nN, gid = wgid / nig, fm = gid * WGM, gsz = (nM - fm) < WGM ? (nM - fm) : WGM;
        u.pm = fm + ((wgid % nig) % gsz); u.pn = (wgid % nig) / gsz; u.kb = 0; u.nk = 0; u.part = 0; return true;
    }
    __device__ __forceinline__ void a_ready(const Unit&) const {}
    __device__ __forceinline__ void done(const Unit&) const {}
};
struct StaggerOrder {
    static constexpr bool HAS_PARK = true, HAS_MID = false;
    StaticOrder so; int n, a, nt;
    __host__ __device__ void init(int M, int N, int G_, int c_, int nt_) { so.init(M, N, G_, c_); nt = nt_; n = c_ < so.nwg ? (so.nwg - c_ + G_ - 1) / G_ : 0;
        a = ((c_ & 7) * (nt_ / 8)) & ~3;
        if (a < 4 || nt_ - a < 4 || n < 2) a = 0; }
    __host__ __device__ bool next(int i, Unit& u) const {
        if (a == 0) return so.next(i, u);
        if (i == 0) { so.next(0, u); u.kb = 0; u.nk = a; u.part = 1; return true; }
        if (i < n) return so.next(i, u);
        if (i == n) { so.next(0, u); u.kb = a; u.nk = nt - a; u.part = 2; return true; }
        return false;
    }
    __device__ __forceinline__ void a_ready(const Unit&) const {}
    __device__ __forceinline__ void done(const Unit&) const {}
};


template <class E> struct epi_stages { static constexpr bool v = false; };
typedef int i32x4 __attribute__((ext_vector_type(4)));
template <bool I8> __device__ __forceinline__ f32x4 mma_op(bf16x8 b, bf16x8 a, f32x4 c) {
    if constexpr (I8) return __builtin_bit_cast(f32x4, __builtin_amdgcn_mfma_i32_16x16x64_i8(__builtin_bit_cast(i32x4, b), __builtin_bit_cast(i32x4, a), __builtin_bit_cast(i32x4, c), 0, 0, 0));
    else return __builtin_amdgcn_mfma_f32_16x16x32_bf16(b, a, c, 0, 0, 0);
}

#ifndef USE_STAGGER
struct GemmOrder : StaticOrder { __host__ __device__ void init(int M, int N, int G_, int c_, int) { StaticOrder::init(M, N, G_, c_); } };
#else
typedef StaggerOrder GemmOrder;
#endif
#define PG8_GAS __attribute__((address_space(1)))

typedef float f32x2_t __attribute__((ext_vector_type(2))); typedef __bf16 bf16x2_t __attribute__((ext_vector_type(2)));
__device__ __forceinline__ unsigned cvt_pk_bf16(float lo, float hi) { const f32x2_t v = {lo, hi}; const bf16x2_t b = __builtin_convertvector(v, bf16x2_t); return __builtin_bit_cast(unsigned, b); }
__device__ __forceinline__ float sigm(float x) { return __builtin_amdgcn_rcpf(1.0f + __builtin_amdgcn_exp2f(-1.4426950409f * x)); }

struct EpiBf16 {
    static constexpr bool PERM = true, AFTER_DRAIN = false;
    bf16_t* O; int ldc; int skip; int sig_tile;
    int hole_tile, hole_cols;
    __device__ __forceinline__ void mid(f32x4 (&acc)[2][2][4][2], const Unit& u, int wr, int wc, int fr, int fq) const {}
    __device__ __forceinline__ void operator()(const f32x4 (&acc)[2][2][4][2], const Unit& u, int wr, int wc, int fr, int fq) const {
        const int row0 = u.pm * BM + wr * 64 + fr; const int col0 = u.pn * BM + wc * 32 + 8 * fq + (u.pn >= hole_tile ? hole_cols : 0);
#ifdef DBG_NULL_EPI
        if (skip) { asm volatile("" :: "v"(acc[0][0][0][0]), "v"(acc[1][1][3][1])); return; }
#endif
        const bool sg = u.pn >= sig_tile;
#pragma unroll
        for (int ai = 0; ai < 2; ++ai)
#pragma unroll
            for (int m = 0; m < 4; ++m) { bf16_t* rowp = O + (size_t)(row0 + ai * HALF + m * 16) * ldc + col0;
#pragma unroll
                for (int bj = 0; bj < 2; ++bj) { f32x4 v0 = acc[ai][bj][m][0], v1 = acc[ai][bj][m][1];
                    if (sg) {
#pragma unroll
                        for (int j = 0; j < 4; ++j) { v0[j] = sigm(v0[j]); v1[j] = sigm(v1[j]); } }
                    u32x4 w; w.x = cvt_pk_bf16(v0[0], v0[1]); w.y = cvt_pk_bf16(v0[2], v0[3]); w.z = cvt_pk_bf16(v1[0], v1[1]); w.w = cvt_pk_bf16(v1[2], v1[3]);
#if defined(EPI_SC1)
                    asm volatile("global_store_dwordx4 %0, %1, off sc1" :: "v"(rowp + bj * HALF), "v"(w) : "memory");
#elif defined(EPI_NT)
                    __builtin_nontemporal_store(w, (u32x4*)(rowp + bj * HALF));
#else
                    *(PG8_GAS u32x4*)(rowp + bj * HALF) = w;
#endif
                    } }
    }
};
struct EpiNull {
    static constexpr bool PERM = true, AFTER_DRAIN = false;
    float* sink;
    __device__ __forceinline__ void mid(f32x4 (&acc)[2][2][4][2], const Unit& u, int wr, int wc, int fr, int fq) const {}
    __device__ __forceinline__ void operator()(const f32x4 (&acc)[2][2][4][2], const Unit& u, int wr, int wc, int fr, int fq) const {
#pragma unroll
        for (int ai = 0; ai < 2; ++ai)
#pragma unroll
            for (int m = 0; m < 4; ++m)
#pragma unroll
                for (int bj = 0; bj < 2; ++bj) { asm volatile("" :: "v"(acc[ai][bj][m][0]), "v"(acc[ai][bj][m][1])); }
    }
};
struct EpiGateI8 {
    static constexpr bool PERM = true, AFTER_DRAIN = false;
    bf16_t* O; int ldc; int col_off; const float* sa; const float* sb;
    PG8_LAS unsigned char* sl;
    __device__ __forceinline__ void stage_issue(float& r, const Unit& n, int tid) const { r = tid < 256 ? ((const PG8_GAS float*)sa)[n.pm * BM + tid] : ((const PG8_GAS float*)sb)[n.pn * BM + tid - 256]; }
    __device__ __forceinline__ void stage_commit(float r, const Unit& n, int tid) const { ((PG8_LAS float*)(sl + n.st * 2048))[tid] = r; }
    __device__ __forceinline__ void dequant(f32x4 (&acc)[2][2][4][2], const Unit& u, int wr, int wc, int fr, int fq) const {}
    __device__ __forceinline__ void mid(f32x4 (&acc)[2][2][4][2], const Unit& u, int wr, int wc, int fr, int fq) const {}
    __device__ __forceinline__ void operator()(const f32x4 (&acc)[2][2][4][2], const Unit& u, int wr, int wc, int fr, int fq) const {
        asm volatile("" : "+v"(fr), "+v"(fq));
        const int row0 = u.pm * BM + wr * 64 + fr; const int col0 = u.pn * BM + wc * 32 + 8 * fq;
        const PG8_LAS float* stg = (const PG8_LAS float*)(sl + u.st * 2048);
        f32x4 sbv[2][2];
#pragma unroll
        for (int bj = 0; bj < 2; ++bj)
#pragma unroll
            for (int n = 0; n < 2; ++n) sbv[bj][n] = *(const PG8_LAS f32x4*)(stg + 256 + wc * 32 + 8 * fq + bj * HALF + 4 * n);
        float sv[2][4];
#pragma unroll
        for (int ai = 0; ai < 2; ++ai)
#pragma unroll
            for (int m = 0; m < 4; ++m) sv[ai][m] = stg[wr * 64 + fr + ai * HALF + m * 16];
#pragma unroll
        for (int ai = 0; ai < 2; ++ai)
#pragma unroll
            for (int m = 0; m < 4; ++m) { const int row = row0 + ai * HALF + m * 16; const float s = sv[ai][m]; bf16_t* rowp = O + (size_t)row * ldc + col0 + (u.pn < 8 ? 2048 : 4096);
                if (u.pn >= 16 && u.pn < 32) {
                    bf16_t* gp = O + (size_t)row * ldc + 8192 + (u.pn - 16) * HALF + wc * 32 + 8 * fq;
                    const i32x4 a0 = __builtin_bit_cast(i32x4, acc[ai][0][m][0]), a1 = __builtin_bit_cast(i32x4, acc[ai][0][m][1]), b0 = __builtin_bit_cast(i32x4, acc[ai][1][m][0]), b1 = __builtin_bit_cast(i32x4, acc[ai][1][m][1]);
                    const f32x4 ta0 = sbv[0][0] * s, ta1 = sbv[0][1] * s, tb0 = sbv[1][0] * s, tb1 = sbv[1][1] * s; float r[8], g1[8];
#pragma unroll
                    for (int j = 0; j < 4; ++j) {
                        const float h0 = 1.0f + __builtin_amdgcn_exp2f(-1.4426950409f * ((float)b0[j] * tb0[j])), h1 = 1.0f + __builtin_amdgcn_exp2f(-1.4426950409f * ((float)b1[j] * tb1[j]));
                        g1[j] = __builtin_amdgcn_rcpf(h0); g1[4 + j] = __builtin_amdgcn_rcpf(h1);
                        r[j] = sigm((float)a0[j] * ta0[j]) * h0; r[4 + j] = sigm((float)a1[j] * ta1[j]) * h1; }
                    u32x4 w; w.x = cvt_pk_bf16(r[0], r[1]); w.y = cvt_pk_bf16(r[2], r[3]); w.z = cvt_pk_bf16(r[4], r[5]); w.w = cvt_pk_bf16(r[6], r[7]);
                    *(PG8_GAS u32x4*)gp = w;
                    w.x = cvt_pk_bf16(g1[0], g1[1]); w.y = cvt_pk_bf16(g1[2], g1[3]); w.z = cvt_pk_bf16(g1[4], g1[5]); w.w = cvt_pk_bf16(g1[6], g1[7]);
                    *(PG8_GAS u32x4*)(gp + 2048) = w;
                    continue; }
#pragma unroll
                for (int bj = 0; bj < 2; ++bj) { const i32x4 i0 = __builtin_bit_cast(i32x4, acc[ai][bj][m][0]), i1 = __builtin_bit_cast(i32x4, acc[ai][bj][m][1]);
                    const f32x4 t0 = sbv[bj][0] * s, t1 = sbv[bj][1] * s; float v[8];
#pragma unroll
                    for (int j = 0; j < 4; ++j) { v[j] = (float)i0[j] * t0[j]; v[4 + j] = (float)i1[j] * t1[j]; }
                    if (u.pn >= 16) {
#pragma unroll
                        for (int j = 0; j < 8; ++j) v[j] = sigm(v[j]); }
                    u32x4 w; w.x = cvt_pk_bf16(v[0], v[1]); w.y = cvt_pk_bf16(v[2], v[3]); w.z = cvt_pk_bf16(v[4], v[5]); w.w = cvt_pk_bf16(v[6], v[7]);
                    *(PG8_GAS u32x4*)(rowp + bj * HALF) = w; } }
    }
};
template <> struct epi_stages<EpiGateI8> { static constexpr bool v = true; };
struct EpiGlu {
    static constexpr bool PERM = true, AFTER_DRAIN = false;
    bf16_t* O; int ldc;
    __device__ __forceinline__ void mid(f32x4 (&acc)[2][2][4][2], const Unit& u, int wr, int wc, int fr, int fq) const {}
    __device__ __forceinline__ void operator()(const f32x4 (&acc)[2][2][4][2], const Unit& u, int wr, int wc, int fr, int fq) const {
        const int row0 = u.pm * BM + wr * 64 + fr; const int col0 = u.pn * HALF + wc * 32 + 8 * fq;
#pragma unroll
        for (int ai = 0; ai < 2; ++ai)
#pragma unroll
            for (int m = 0; m < 4; ++m) { bf16_t* rowp = O + (size_t)(row0 + ai * HALF + m * 16) * ldc + col0;
                const f32x4 a0 = acc[ai][0][m][0], a1 = acc[ai][0][m][1], g0 = acc[ai][1][m][0], g1 = acc[ai][1][m][1];
                float o[8];
#pragma unroll
                for (int j = 0; j < 4; ++j) { o[j] = a0[j] * sigm(g0[j]); o[4 + j] = a1[j] * sigm(g1[j]); }
                u32x4 w; w.x = cvt_pk_bf16(o[0], o[1]); w.y = cvt_pk_bf16(o[2], o[3]); w.z = cvt_pk_bf16(o[4], o[5]); w.w = cvt_pk_bf16(o[6], o[7]);
                *(PG8_GAS u32x4*)rowp = w; }
    }
};
template <int CTRL> __device__ __forceinline__ float dpp_mov_old(float oldv, float x) {
    return __builtin_bit_cast(float, __builtin_amdgcn_update_dpp(__builtin_bit_cast(int, oldv), __builtin_bit_cast(int, x), CTRL, 0xf, 0xf, false)); }
template <int CTRL> __device__ __forceinline__ float dpp_mov_any(float x) {
    return __builtin_bit_cast(float, __builtin_amdgcn_mov_dpp(__builtin_bit_cast(int, x), CTRL, 0xf, 0xf, false)); }
__device__ __forceinline__ float gelu_mul(float a, float v) {
    const float t = a * ((a * a) * -0.1029432396f + -2.3022081986f);
    return (a * v) * __builtin_amdgcn_rcpf(1.0f + __builtin_amdgcn_exp2f(t)); }
__device__ __forceinline__ float gelu_t(float a) { const float u = a * (1.0f + 0.044715f * a * a); return a * sigm(1.5957691216f * u); }
typedef unsigned u32x2 __attribute__((ext_vector_type(2)));
template <bool Q8> struct EpiUpConv {
    static constexpr bool PERM = true, AFTER_DRAIN = false;
    bf16_t* act; bf16_t* raw; const float* cw; const float* cb; int dff, nup;
    const float* sa; const float* sb;
    __device__ __forceinline__ void dequant(f32x4 (&acc)[2][2][4][2], const Unit& u, int wr, int wc, int fr, int fq) const {
    }
    __device__ __forceinline__ void mid(f32x4 (&acc)[2][2][4][2], const Unit& u, int wr, int wc, int fr, int fq) const {}
    __device__ __forceinline__ void operator()(const f32x4 (&acc)[2][2][4][2], const Unit& u, int wr, int wc, int fr, int fq) const {
        asm volatile("" : "+v"(fr), "+v"(fq));
        const int cl0 = u.pn * HALF + wc * 32 + 8 * fq;
        float srr[2][4];
#pragma unroll
        for (int ai = 0; ai < 2; ++ai)
#pragma unroll
            for (int m = 0; m < 4; ++m) srr[ai][m] = Q8 ? ((const PG8_GAS float*)sa)[u.pm * BM + ai * HALF + wr * 64 + 16 * m + fr] : 1.0f;
        f32x4 wa[3], wv[3], ba, bv;
#define UPC_LOADW(n_) do { const int cl_ = cl0 + 4 * (n_); \
            _Pragma("unroll") for (int jj = 0; jj < 3; ++jj) { wa[jj] = *(const PG8_GAS f32x4*)(cw + (size_t)jj * nup + cl_); wv[jj] = *(const PG8_GAS f32x4*)(cw + (size_t)jj * nup + dff + cl_); } \
            ba = *(const PG8_GAS f32x4*)(cb + cl_); bv = *(const PG8_GAS f32x4*)(cb + dff + cl_); \
            if (Q8) { const f32x4 sba = *(const PG8_GAS f32x4*)(sb + u.pn * BM + wc * 32 + 8 * fq + 4 * (n_)), sbv = *(const PG8_GAS f32x4*)(sb + u.pn * BM + HALF + wc * 32 + 8 * fq + 4 * (n_)); \
                _Pragma("unroll") for (int jj = 0; jj < 3; ++jj) { wa[jj] = wa[jj] * sba; wv[jj] = wv[jj] * sbv; } } } while (0)
        UPC_LOADW(0);
#pragma unroll
        for (int ai = 0; ai < 2; ++ai) asm volatile("" : "+v"(srr[ai][0]), "+v"(srr[ai][1]), "+v"(srr[ai][2]), "+v"(srr[ai][3]));
#pragma unroll
        for (int n = 0; n < 2; ++n) {
            const int cl = cl0 + 4 * n;
#pragma unroll
            for (int ai = 0; ai < 2; ++ai) {
                const int rowb = u.pm * BM + ai * HALF + wr * 64;
                float o[4][4];
#pragma unroll
                for (int j = 0; j < 4; ++j) {
                    float pa = 0.f, pv = 0.f;
#pragma unroll
                    for (int m = 0; m < 4; ++m) {
                        const i32x4 ia_ = __builtin_bit_cast(i32x4, acc[ai][0][m][n]), iv_ = __builtin_bit_cast(i32x4, acc[ai][1][m][n]);
                        const float xa = Q8 ? (float)ia_[j] * srr[ai][m] : acc[ai][0][m][n][j];
                        const float xv = Q8 ? (float)iv_[j] * srr[ai][m] : acc[ai][1][m][n][j];
                        const float a1 = dpp_mov_old<0x111>(dpp_mov_any<0x121>(pa), xa), a2 = dpp_mov_old<0x112>(dpp_mov_any<0x122>(pa), xa);
                        const float v1 = dpp_mov_old<0x111>(dpp_mov_any<0x121>(pv), xv), v2 = dpp_mov_old<0x112>(dpp_mov_any<0x122>(pv), xv);
                        const float ya = wa[0][j] * a2 + (wa[1][j] * a1 + (wa[2][j] * xa + ba[j]));
                        const float yv = wv[0][j] * v2 + (wv[1][j] * v1 + (wv[2][j] * xv + bv[j]));
                        o[m][j] = gelu_mul(ya, yv);
                        pa = xa; pv = xv; } }
                u32x2 w2[4];
#pragma unroll
                for (int m = 0; m < 4; ++m) { w2[m].x = cvt_pk_bf16(o[m][0], o[m][1]); w2[m].y = cvt_pk_bf16(o[m][2], o[m][3]); }
                if (n == 0 && ai == 1) { asm volatile("" ::: "memory"); UPC_LOADW(1); asm volatile("" ::: "memory"); }
#pragma unroll
                for (int m = 0; m < 4; ++m) *(PG8_GAS u32x2*)(act + (size_t)(rowb + 16 * m + fr) * dff + cl) = w2[m];
                asm volatile("" ::: "memory");
            }
        }
#undef UPC_LOADW
#pragma unroll
        for (int ai = 0; ai < 2; ++ai) {
            const int rowb = u.pm * BM + ai * HALF + wr * 64; const float* sr = srr[ai];
            const int ridx = fr < 2 ? fr : fr - 12;
            if (fr < 2 || fr >= 14) { const int m = fr < 2 ? 0 : 3;
                f32x4 a0 = fr < 2 ? acc[ai][0][0][0] : acc[ai][0][3][0], a1 = fr < 2 ? acc[ai][0][0][1] : acc[ai][0][3][1];
                f32x4 v0 = fr < 2 ? acc[ai][1][0][0] : acc[ai][1][3][0], v1 = fr < 2 ? acc[ai][1][0][1] : acc[ai][1][3][1];
                if (Q8) { const float s = fr < 2 ? sr[0] : sr[3];
                    const i32x4 ia0 = __builtin_bit_cast(i32x4, a0), ia1 = __builtin_bit_cast(i32x4, a1), iv0 = __builtin_bit_cast(i32x4, v0), iv1 = __builtin_bit_cast(i32x4, v1);
                    a0 = (f32x4){(float)ia0[0], (float)ia0[1], (float)ia0[2], (float)ia0[3]} * s; a1 = (f32x4){(float)ia1[0], (float)ia1[1], (float)ia1[2], (float)ia1[3]} * s;
                    v0 = (f32x4){(float)iv0[0], (float)iv0[1], (float)iv0[2], (float)iv0[3]} * s; v1 = (f32x4){(float)iv1[0], (float)iv1[1], (float)iv1[2], (float)iv1[3]} * s; }
                bf16_t* rp = raw + ((size_t)(rowb >> 6) * 4 + ridx) * 2 * dff + cl0; (void)m;
                *(PG8_GAS u32x4*)rp = (u32x4){cvt_pk_bf16(a0[0], a0[1]), cvt_pk_bf16(a0[2], a0[3]), cvt_pk_bf16(a1[0], a1[1]), cvt_pk_bf16(a1[2], a1[3])};
                *(PG8_GAS u32x4*)(rp + dff) = (u32x4){cvt_pk_bf16(v0[0], v0[1]), cvt_pk_bf16(v0[2], v0[3]), cvt_pk_bf16(v1[0], v1[1]), cvt_pk_bf16(v1[2], v1[3])}; }
        }
    }
};
struct EpiBranch {
    static constexpr bool PERM = true, AFTER_DRAIN = false;
    const bf16_t* proj; int ldp; int gate_col; bf16_t* merged; const bf16_t* ones;
    __device__ __forceinline__ void mid(f32x4 (&acc)[2][2][4][2], const Unit& u, int wr, int wc, int fr, int fq) const {
        const int n = u.pn >> 3, pn = u.pn & 7, pm = u.pm & 31;
        const int row0 = pm * BM + wr * 64 + fr; const int col0 = pn * BM + wc * 32 + 8 * fq;
#pragma unroll
        for (int ai = 0; ai < 2; ++ai)
#pragma unroll
            for (int mp = 0; mp < 1; ++mp) {
                u32x4 ga[4][2], gb[4][2];
#pragma unroll
                for (int mm = 0; mm < 4; ++mm)
#pragma unroll
                    for (int bj = 0; bj < 2; ++bj) { const bf16_t* gp = proj + (size_t)(row0 + ai * HALF + mm * 16) * ldp + gate_col + n * 2048 + col0 + bj * HALF;
                        ga[mm][bj] = *(const PG8_GAS u32x4*)gp; gb[mm][bj] = *(const PG8_GAS u32x4*)(n == 0 ? ones : gp + 2048); }
#pragma unroll
                for (int mm = 0; mm < 4; ++mm)
#pragma unroll
                    for (int bj = 0; bj < 2; ++bj) { const int m = mm; const u32x4 a = ga[mm][bj], b = gb[mm][bj];
                        f32x4 v0 = acc[ai][bj][m][0], v1 = acc[ai][bj][m][1];
                        v0[0] *= __uint_as_float(a.x << 16) * __builtin_amdgcn_rcpf(__uint_as_float(b.x << 16)); v0[1] *= __uint_as_float(a.x & 0xffff0000u) * __builtin_amdgcn_rcpf(__uint_as_float(b.x & 0xffff0000u));
                        v0[2] *= __uint_as_float(a.y << 16) * __builtin_amdgcn_rcpf(__uint_as_float(b.y << 16)); v0[3] *= __uint_as_float(a.y & 0xffff0000u) * __builtin_amdgcn_rcpf(__uint_as_float(b.y & 0xffff0000u));
                        v1[0] *= __uint_as_float(a.z << 16) * __builtin_amdgcn_rcpf(__uint_as_float(b.z << 16)); v1[1] *= __uint_as_float(a.z & 0xffff0000u) * __builtin_amdgcn_rcpf(__uint_as_float(b.z & 0xffff0000u));
                        v1[2] *= __uint_as_float(a.w << 16) * __builtin_amdgcn_rcpf(__uint_as_float(b.w << 16)); v1[3] *= __uint_as_float(a.w & 0xffff0000u) * __builtin_amdgcn_rcpf(__uint_as_float(b.w & 0xffff0000u));
                        acc[ai][bj][m][0] = v0; acc[ai][bj][m][1] = v1; }
                asm volatile("" ::: "memory"); }
    }
    __device__ __forceinline__ void operator()(const f32x4 (&acc)[2][2][4][2], const Unit& u, int wr, int wc, int fr, int fq) const {
        const int n = u.pn >> 3, pn = u.pn & 7, pm = u.pm & 31;
        const int row0 = pm * BM + wr * 64 + fr; const int col0 = pn * BM + wc * 32 + 8 * fq;
        u32x4 gcur[2], gnxt[2];
#pragma unroll
        for (int bj = 0; bj < 2; ++bj) gcur[bj] = *(const PG8_GAS u32x4*)(proj + (size_t)row0 * ldp + gate_col + n * 2048 + col0 + bj * HALF);
#pragma unroll
        for (int it = 0; it < 8; ++it) { const int ai = it >> 2, m = it & 3; const size_t row = (size_t)(row0 + ai * HALF + m * 16);
            if (it + 1 < 8) { const size_t rown = (size_t)(row0 + ((it + 1) >> 2) * HALF + ((it + 1) & 3) * 16);
#pragma unroll
                for (int bj = 0; bj < 2; ++bj) gnxt[bj] = *(const PG8_GAS u32x4*)(proj + rown * ldp + gate_col + n * 2048 + col0 + bj * HALF); }
#pragma unroll
            for (int bj = 0; bj < 2; ++bj) { const int col = col0 + bj * HALF; const u32x4 gw = gcur[bj];
                f32x4 v0 = acc[ai][bj][m][0], v1 = acc[ai][bj][m][1];
                v0[0] *= __uint_as_float(gw.x << 16); v0[1] *= __uint_as_float(gw.x & 0xffff0000u); v0[2] *= __uint_as_float(gw.y << 16); v0[3] *= __uint_as_float(gw.y & 0xffff0000u);
                v1[0] *= __uint_as_float(gw.z << 16); v1[1] *= __uint_as_float(gw.z & 0xffff0000u); v1[2] *= __uint_as_float(gw.w << 16); v1[3] *= __uint_as_float(gw.w & 0xffff0000u);
                u32x4 w; w.x = cvt_pk_bf16(v0[0], v0[1]); w.y = cvt_pk_bf16(v0[2], v0[3]); w.z = cvt_pk_bf16(v1[0], v1[1]); w.w = cvt_pk_bf16(v1[2], v1[3]);
                *(PG8_GAS u32x4*)(merged + row * 2048 + col) = w; }
            asm volatile("" ::: "memory");
            gcur[0] = gnxt[0]; gcur[1] = gnxt[1]; }
    }
};
struct BranchOrder {
    static constexpr bool HAS_PARK = false, HAS_MID = true;
    StaticOrder so; int G, c;
    __host__ __device__ void init(int G_, int c_) { so.init(32 * BM, 8 * BM, 1, 0); G = G_; c = c_; }
    __host__ __device__ bool next(int i, Unit& u) const {
        const int tile = (i / 3) * G + c, n = i % 3; if (tile >= 256) return false;
        Unit t; so.next(tile, t); u = t; u.pm = t.pm + 32 * n; u.pn = t.pn + 8 * n; u.part = n < 2 ? 3 : 0; return true;
    }
    __device__ __forceinline__ void a_ready(const Unit&) const {}
    __device__ __forceinline__ void done(const Unit&) const {}
};
template <class Epi, class Sched, bool ALIGN_EPI = false, bool SP2 = false, bool I8 = false>
__device__ __forceinline__ void gemm_phase(PG8_LAS unsigned char* lds, const Gemm g, const Sched& S, const Epi& E) {
    int tid_ = threadIdx.x; asm volatile("" : "+v"(tid_)); const int tid = tid_, wid = __builtin_amdgcn_readfirstlane(tid >> 6), lane = tid & 63, wr = wid >> 2, wc = wid & 3, fr = lane & 15, fq = lane >> 4;
    const int K = I8 ? g.K / 2 : g.K, nt = K / BK;
    unsigned voffA[2], voffB[2];
#pragma unroll
    for (int i = 0; i < 2; ++i) { int R, C; stage_rc(tid * 16 + i * 8192, R, C); const int Rb = Epi::PERM ? ((R & ~31) + perm32(R & 31)) : R;
        voffA[i] = (unsigned)(R * K + C) * 2u; voffB[i] = (unsigned)(Rb * K + C) * 2u; }
    const size_t kstep = (size_t)(BK * 2);
    const size_t hstep = (size_t)HALF * K * 2;
    const size_t tstep = 2 * hstep;
    const unsigned ldsw = (unsigned)wid * 1024u;
    const int aoff = lds_byte(wr * 64 + fr, fq * 8), boff = lds_byte(wc * 32 + fr, fq * 8);
#define PG8_SA(b, h) (((b) * 2 + (h)) * HTB)
#define PG8_SB(b, h) ((4 + (b) * 2 + (h)) * HTB)
#define PG8_STAGE(bufoff, gbase, voff) do { _Pragma("unroll") for (int _i = 0; _i < 2; ++_i) \
        __builtin_amdgcn_global_load_lds((const unsigned*)((const char*)(gbase) + (voff)[_i]), (PG8_LAS unsigned*)(lds + (bufoff) + ldsw + _i * 8192), 16, 0, 0); } while (0)
#define PG8_LDA(dst, b, h) do { _Pragma("unroll") for (int m = 0; m < 4; ++m) _Pragma("unroll") for (int k = 0; k < 2; ++k) dst[m][k] = *(const PG8_LAS bf16x8*)(lds + PG8_SA(b, h) + aoff + m * 2048 + k * 1024); } while (0)
#define PG8_LDB(dst, b, h) do { _Pragma("unroll") for (int n = 0; n < 2; ++n) _Pragma("unroll") for (int k = 0; k < 2; ++k) dst[n][k] = *(const PG8_LAS bf16x8*)(lds + PG8_SB(b, h) + boff + n * 2048 + k * 1024); } while (0)
#define PG8_MMA(ai, bj, At, Bt) do { __builtin_amdgcn_s_setprio(1); _Pragma("unroll") for (int m = 0; m < 4; ++m) _Pragma("unroll") for (int n = 0; n < 2; ++n) _Pragma("unroll") for (int k = 0; k < 2; ++k) \
        acc[ai][bj][m][n] = mma_op<I8>(Bt[n][k], At[m][k], acc[ai][bj][m][n]); __builtin_amdgcn_s_setprio(0); } while (0)
#define PG8_WAIT_V(n) asm volatile("s_waitcnt vmcnt(" #n ")" ::: "memory")
#define PG8_WAIT_L(n) asm volatile("s_waitcnt lgkmcnt(" #n ")" ::: "memory")
#define PG8_BAR __builtin_amdgcn_s_barrier()
#define PG8_SCHED __builtin_amdgcn_sched_barrier(0)
    Unit cur, nxt; int ui = 0;
    if (!S.next(0, cur)) return;
    f32x4 acc[2][2][4][2];
#pragma unroll
    for (int a = 0; a < 2; ++a)
#pragma unroll
        for (int b = 0; b < 2; ++b)
#pragma unroll
            for (int m = 0; m < 4; ++m)
#pragma unroll
                for (int n = 0; n < 2; ++n) acc[a][b][m][n] = (f32x4){0.f, 0.f, 0.f, 0.f};
    bf16x8 At[4][2], B0[2][2], B1[2][2];
    cur.st = 0;
    if constexpr (epi_stages<Epi>::v) { float r_; E.stage_issue(r_, cur, tid); E.stage_commit(r_, cur, tid); }
    const char* cA = (const char*)g.A + (size_t)cur.pm * tstep + (size_t)cur.kb * kstep; const char* cB = (const char*)g.Bt + (size_t)cur.pn * tstep + (size_t)cur.kb * kstep;
    S.a_ready(cur);
    if constexpr (SP2) {
        PG8_STAGE(PG8_SB(0, 0), cB, voffB); PG8_STAGE(PG8_SB(0, 1), cB + hstep, voffB); PG8_STAGE(PG8_SA(0, 0), cA, voffA); PG8_STAGE(PG8_SA(0, 1), cA + hstep, voffA);
        if (wr == 1) PG8_BAR;
        PG8_WAIT_V(2); PG8_BAR;
        PG8_STAGE(PG8_SB(1, 0), cB + kstep, voffB); PG8_STAGE(PG8_SA(1, 0), cA + kstep, voffA); PG8_STAGE(PG8_SB(1, 1), cB + hstep + kstep, voffB);
        PG8_WAIT_V(6); PG8_BAR;
    } else {
        PG8_STAGE(PG8_SB(0, 0), cB, voffB); PG8_STAGE(PG8_SA(0, 0), cA, voffA); PG8_STAGE(PG8_SB(0, 1), cB + hstep, voffB); PG8_STAGE(PG8_SA(0, 1), cA + hstep, voffA);
        if (wr == 1) PG8_BAR;
        PG8_WAIT_V(4); PG8_BAR;
        PG8_STAGE(PG8_SB(1, 0), cB + kstep, voffB); PG8_STAGE(PG8_SA(1, 0), cA + kstep, voffA); PG8_STAGE(PG8_SB(1, 1), cB + hstep + kstep, voffB);
        PG8_WAIT_V(6); PG8_BAR;
    }
    for (;;) {
        const bool has_next = S.next(ui + 1, nxt); nxt.st = (ui + 1) & 1;
        const char* nA = has_next ? (const char*)g.A + (size_t)nxt.pm * tstep + (size_t)nxt.kb * kstep : cA; const char* nB = has_next ? (const char*)g.Bt + (size_t)nxt.pn * tstep + (size_t)nxt.kb * kstep : cB;
        const int unt = cur.nk ? cur.nk : nt;
        for (int t = 0; t < unt; t += 2) {
            const bool last = (t == unt - 2);
            const char* a1 = cA + (size_t)(t + 1) * kstep;
            const char* a2 = last ? nA : cA + (size_t)(t + 2) * kstep; const char* b2 = last ? nB : cB + (size_t)(t + 2) * kstep;
            const char* a3 = a2 + kstep; const char* b3 = b2 + kstep;
            if (last && has_next) S.a_ready(nxt);
            if constexpr (SP2) {
            PG8_LDB(B0, 0, 0); PG8_LDB(B1, 0, 1); PG8_SCHED; PG8_LDA(At, 0, 0); PG8_STAGE(PG8_SA(1, 1), a1 + hstep, voffA);
            PG8_WAIT_V(8); PG8_WAIT_L(0); PG8_BAR; PG8_MMA(0, 0, At, B0); PG8_MMA(0, 1, At, B1); PG8_BAR; PG8_SCHED;
            PG8_LDA(At, 0, 1); PG8_STAGE(PG8_SB(0, 0), b2, voffB); PG8_STAGE(PG8_SB(0, 1), b2 + hstep, voffB); PG8_STAGE(PG8_SA(0, 0), a2, voffA);
            PG8_WAIT_V(8); PG8_WAIT_L(0); PG8_BAR; PG8_MMA(1, 0, At, B0); PG8_MMA(1, 1, At, B1); PG8_BAR; PG8_SCHED;
            PG8_LDB(B0, 1, 0); PG8_LDB(B1, 1, 1); PG8_SCHED; PG8_LDA(At, 1, 0); PG8_STAGE(PG8_SA(0, 1), a2 + hstep, voffA);
            PG8_WAIT_V(8); PG8_WAIT_L(0); PG8_BAR; PG8_MMA(0, 0, At, B0); PG8_MMA(0, 1, At, B1); PG8_BAR; PG8_SCHED;
            PG8_LDA(At, 1, 1); PG8_STAGE(PG8_SB(1, 0), b3, voffB); PG8_STAGE(PG8_SB(1, 1), b3 + hstep, voffB); PG8_STAGE(PG8_SA(1, 0), a3, voffA);
            PG8_WAIT_V(8); PG8_WAIT_L(0); PG8_BAR; PG8_MMA(1, 0, At, B0); PG8_MMA(1, 1, At, B1); PG8_BAR; PG8_SCHED;
            } else {
            PG8_LDB(B0, 0, 0); PG8_SCHED; PG8_LDA(At, 0, 0); PG8_STAGE(PG8_SA(1, 1), a1 + hstep, voffA);
            PG8_WAIT_L(8); PG8_BAR; PG8_WAIT_L(0); PG8_MMA(0, 0, At, B0); PG8_BAR; PG8_SCHED;
            PG8_LDB(B1, 0, 1); PG8_STAGE(PG8_SB(0, 0), b2, voffB);
            PG8_BAR; PG8_WAIT_L(0); PG8_MMA(0, 1, At, B1); PG8_BAR;
            PG8_LDA(At, 0, 1); PG8_STAGE(PG8_SA(0, 0), a2, voffA);
            PG8_BAR; PG8_WAIT_L(0); PG8_MMA(1, 0, At, B0); PG8_BAR; PG8_SCHED;
            PG8_STAGE(PG8_SB(0, 1), b2 + hstep, voffB);
            PG8_WAIT_V(6); PG8_BAR; PG8_MMA(1, 1, At, B1); PG8_BAR;
            PG8_LDB(B0, 1, 0); PG8_SCHED; PG8_LDA(At, 1, 0); PG8_STAGE(PG8_SA(0, 1), a2 + hstep, voffA);
            PG8_WAIT_L(8); PG8_BAR; PG8_WAIT_L(0); PG8_MMA(0, 0, At, B0); PG8_BAR; PG8_SCHED;
            PG8_LDB(B1, 1, 1); PG8_STAGE(PG8_SB(1, 0), b3, voffB);
            PG8_BAR; PG8_WAIT_L(0); PG8_MMA(0, 1, At, B1); PG8_BAR;
            PG8_LDA(At, 1, 1); PG8_STAGE(PG8_SA(1, 0), a3, voffA);
            PG8_BAR; PG8_WAIT_L(0); PG8_MMA(1, 0, At, B0); PG8_BAR; PG8_SCHED;
            PG8_STAGE(PG8_SB(1, 1), b3 + hstep, voffB);
            PG8_WAIT_V(6); PG8_BAR; PG8_MMA(1, 1, At, B1); PG8_BAR;
            }
        }
        if constexpr (ALIGN_EPI) { if (wr == 0) PG8_BAR; }
        if constexpr (!Epi::AFTER_DRAIN) {
            if (Sched::HAS_PARK && cur.part == 1) {
                char* pb = (char*)g.pbuf + tid * 16;
#pragma unroll
                for (int a = 0; a < 2; ++a)
#pragma unroll
                    for (int b = 0; b < 2; ++b)
#pragma unroll
                        for (int m = 0; m < 4; ++m)
#pragma unroll
                            for (int n = 0; n < 2; ++n) { *(f32x4*)pb = acc[a][b][m][n]; pb += 8192; asm volatile("" : "+v"(pb)); }
            } else if (Sched::HAS_MID && cur.part == 3) { E.mid(acc, cur, wr, wc, fr, fq);
            } else { if constexpr (I8) E.dequant(acc, cur, wr, wc, fr, fq);
                float sg_ = 0.f; if constexpr (epi_stages<Epi>::v) { if (has_next) E.stage_issue(sg_, nxt, tid); }
                E(acc, cur, wr, wc, fr, fq);
                if constexpr (epi_stages<Epi>::v) { if (has_next) E.stage_commit(sg_, nxt, tid); }
                S.done(cur); } }
        if (!has_next) break;
        if (Sched::HAS_PARK && nxt.part == 2) {
            const char* pb = (const char*)g.pbuf + tid * 16;
#pragma unroll
            for (int a = 0; a < 2; ++a)
#pragma unroll
                for (int b = 0; b < 2; ++b)
#pragma unroll
                    for (int m = 0; m < 4; ++m)
#pragma unroll
                        for (int n = 0; n < 2; ++n) { acc[a][b][m][n] = *(const f32x4*)pb; pb += 8192; asm volatile("" : "+v"(pb)); }
        } else if (!(Sched::HAS_MID && cur.part == 3))
#pragma unroll
        for (int a = 0; a < 2; ++a)
#pragma unroll
            for (int b = 0; b < 2; ++b)
#pragma unroll
                for (int m = 0; m < 4; ++m)
#pragma unroll
                    for (int n = 0; n < 2; ++n) acc[a][b][m][n] = (f32x4){0.f, 0.f, 0.f, 0.f};
        cur = nxt; cA = nA; cB = nB; ++ui;
        if constexpr (ALIGN_EPI) { if (wr == 1) PG8_BAR; }
    }
    PG8_WAIT_V(0);
    if constexpr (!ALIGN_EPI) { if (wr == 0) PG8_BAR; }
    PG8_BAR;
    if constexpr (Epi::AFTER_DRAIN) { E.fused(acc, cur, wr, wc, fr, fq, lds, wid, lane); S.done(cur); }
#undef PG8_SA
#undef PG8_SB
#undef PG8_STAGE
#undef PG8_LDA
#undef PG8_LDB
#undef PG8_MMA
#undef PG8_WAIT_V
#undef PG8_WAIT_L
#undef PG8_BAR
#undef PG8_SCHED
}
}

constexpr int D = 2048, NBATCH = 16, L = 2048, M = NBATCH * L;
constexpr int MC = 8192, NCH = 4, DEPTH = 2;
constexpr int NIN = 14344, NP = 14336;
constexpr int C_QM = 0, C_KM = 1024, C_VM = 2048, C_OM = 3072, C_QD = 4096, C_KD = 5120, C_VD = 6144, C_US = 7168, C_GATE = 8192;
constexpr int DFF = 5632, NUP = 2 * DFF;
constexpr float EPS = 1e-6f;
constexpr int NWAVES = 8, NTHR = 512;

constexpr size_t MiB = 1u << 20;
constexpr size_t WS_CTL = 0, CTL_ZERO_BYTES = 1 * MiB;
constexpr size_t WS_TAB = 1 * MiB;
constexpr size_t T_WIF = WS_TAB, T_BIAS = WS_TAB + 131072, T_S5A = WS_TAB + 262144, T_BBT = WS_TAB + 524288, T_CT = WS_TAB + 1048576;
constexpr size_t T_SA_FFN = 2560 * 1024, T_SA_MIX = 2688 * 1024, T_SB_UP = 2816 * 1024, T_SB_G = 2880 * 1024, T_ONES = 2944 * 1024, T_LAM = 2945 * 1024;
constexpr size_t WS_XN8F = 150 * MiB + 64 * MiB;
constexpr size_t WS_WIN = 4 * MiB, WS_WGLU = 60 * MiB, WS_WB = 64 * MiB, WS_WOUT = 76 * MiB, WS_WUP = 84 * MiB, WS_WDN = 128 * MiB;
constexpr size_t WS_XN = 150 * MiB, WS_IFG = 278 * MiB;
constexpr size_t WS_PROJ = 280 * MiB, WS_QKC = 504 * MiB, WS_HM = 536 * MiB, WS_O12 = 552 * MiB, WS_YS5 = 584 * MiB, WS_Y = 600 * MiB, WS_MERGED = 648 * MiB;
constexpr size_t WS_XN8M = 776 * MiB;
constexpr size_t WS_WG8 = 4 * MiB + 16 * MiB;
constexpr size_t WS_MIX = 280 * MiB;
constexpr int MH = 16384;
constexpr size_t WS_ACT = 280 * MiB, WS_FFN = 456 * MiB;
constexpr size_t WS_XB = 872 * MiB;
constexpr size_t WS_PBUF = 0;
constexpr size_t WS_RAW = 1000 * MiB;
constexpr size_t WS_END = 1022 * MiB;
static_assert(WS_WIN + (size_t)NP * D * 2 <= WS_WGLU && WS_WGLU + (size_t)2048 * 1024 * 2 <= WS_WB && WS_WB + (size_t)3 * 2048 * 1024 * 2 <= WS_WOUT && WS_WOUT + (size_t)D * D * 2 <= WS_WUP && WS_WUP + (size_t)NUP * D * 2 <= WS_WDN && WS_WDN + (size_t)D * DFF * 2 <= WS_XN, "ws map: weights");
static_assert(WS_XN + (size_t)M * D * 2 <= WS_IFG && WS_PROJ + (size_t)MC * NP * 2 <= WS_QKC && WS_Y + (size_t)3 * MC * 1024 * 2 <= WS_MERGED && WS_MERGED + (size_t)M * D * 2 <= WS_XN8M, "ws map: mixer");
static_assert(WS_MIX + (size_t)M * D * 2 <= WS_MERGED && WS_ACT + (size_t)MH * DFF * 2 <= WS_FFN && WS_FFN + (size_t)MH * D * 2 <= WS_XN8M && WS_XN8M + (size_t)M * D <= WS_XB && WS_XB + (size_t)M * D * 2 <= WS_END, "ws map: ffn");
constexpr int CW_QUEUE = 64;
constexpr int CW_BAR = 4096;
constexpr int CW_COLMAX = 65536, NI8 = 10240;

constexpr int LDS_BYTES = 147456, LDSCTL_OFF = 143360;

#define GAS __attribute__((address_space(1)))
#define LAS __attribute__((address_space(3)))
#define DI __device__ __forceinline__
typedef unsigned short bf16;
typedef unsigned v4u __attribute__((ext_vector_type(4)));
typedef unsigned v2u __attribute__((ext_vector_type(2)));
typedef float f32x4 __attribute__((ext_vector_type(4)));
typedef float f32x2 __attribute__((ext_vector_type(2)));
typedef short bf16x8 __attribute__((ext_vector_type(8)));
typedef short s16x4 __attribute__((ext_vector_type(4)));
typedef GAS unsigned gu32;
#define RLX_AGENT __ATOMIC_RELAXED, __HIP_MEMORY_SCOPE_AGENT
#define LDS_WAIT() asm volatile("s_waitcnt lgkmcnt(0)" ::: "memory")
#ifdef P0_NT_LD
#define P0_LD(p_) __builtin_nontemporal_load(p_)
#else
#define P0_LD(p_) (*(p_))
#endif
#define VM_WAIT() asm volatile("s_waitcnt vmcnt(0)" ::: "memory")
#define MFMA16(a, b, c) __builtin_amdgcn_mfma_f32_16x16x32_bf16((a), (b), (c), 0, 0, 0)
#define SB() __builtin_amdgcn_sched_barrier(0)
#ifndef NOSB1
#define SB1() SB()
#else
#define SB1()
#endif
#if 0
#define SB2() SB()
#else
#define SB2()
#endif
#ifndef NOSB3
#define SB3() SB()
#else
#define SB3()
#endif
DI unsigned f2bf(float f) { unsigned u = __builtin_bit_cast(unsigned, f); return (u + 0x7fffu + ((u >> 16) & 1u)) >> 16; }
DI unsigned pk2(float lo, float hi) { return pg8::cvt_pk_bf16(lo, hi); }
DI float bflo(unsigned w) { return __uint_as_float(w << 16); }
DI float bfhi(unsigned w) { return __uint_as_float(w & 0xffff0000u); }
DI float bf2f(bf16 b) { return __uint_as_float(((unsigned)b) << 16); }
DI float ex2(float x) { return __builtin_amdgcn_exp2f(x); }
DI float expf_(float x) { return __builtin_amdgcn_exp2f(x * 1.4426950409f); }
DI float sigm(float x) { return __builtin_amdgcn_rcpf(1.0f + __builtin_amdgcn_exp2f(-1.4426950409f * x)); }
DI float gelu_tanh(float a) { const float u = a * (1.0f + 0.044715f * a * a); return a * sigm(1.5957691216f * u); }
DI float wave_sum(float v) {
#pragma unroll
    for (int o = 1; o < 64; o <<= 1) v += __shfl_xor(v, o);
    return v;
}
DI float wave_max(float v) {
#pragma unroll
    for (int o = 1; o < 64; o <<= 1) v = fmaxf(v, __shfl_xor(v, o));
    return v;
}
DI unsigned pack_i8(f32x4 v, float inv) {
    const int a = (int)__builtin_rintf(v.x * inv), b = (int)__builtin_rintf(v.y * inv), c = (int)__builtin_rintf(v.z * inv), d = (int)__builtin_rintf(v.w * inv);
    return (unsigned)(a & 255) | ((unsigned)(b & 255) << 8) | ((unsigned)(c & 255) << 16) | ((unsigned)d << 24);
}
DI bf16x8 tr8(const LAS unsigned char* p0, const LAS unsigned char* p1) {
    typedef short v4i16_t __attribute__((ext_vector_type(4)));
    const s16x4 lo = __builtin_bit_cast(s16x4, __builtin_amdgcn_ds_read_tr16_b64_v4i16((LAS v4i16_t*)p0));
    const s16x4 hi = __builtin_bit_cast(s16x4, __builtin_amdgcn_ds_read_tr16_b64_v4i16((LAS v4i16_t*)p1));
    return __builtin_shufflevector(lo, hi, 0, 1, 2, 3, 4, 5, 6, 7);
}

struct Frame {
    LAS unsigned char* lds;
    volatile LAS unsigned* MISC;
    gu32* ctl;
    int tid, lane, wave, G, bid;
    unsigned char* ws;
    const float* const* in;
    float* out;
};

DI void p0_transpose_item(const float* W, int ldw, int K, int src_col0, bf16* WT, int dst_row0, LAS float* scr, int kb, int lane) {
    const int k0 = 64 * kb, kr = lane >> 3, nc = lane & 7;
    f32x4 v[8];
#pragma unroll
    for (int i = 0; i < 8; ++i) v[i] = P0_LD((const GAS f32x4*)(W + (size_t)(k0 + kr + 8 * i) * ldw + src_col0 + 4 * nc));
#pragma unroll
    for (int i = 0; i < 8; ++i) *(LAS f32x4*)(scr + (kr + 8 * i) * 36 + 4 * nc) = v[i];
    LDS_WAIT(); asm volatile("" ::: "memory");
    const int c = lane & 7;
#pragma unroll
    for (int j = 0; j < 4; ++j) { const int n = (lane >> 3) + 8 * j; const LAS float* s = scr + (8 * c) * 36 + n;
        v4u o; o.x = pk2(s[0 * 36], s[1 * 36]); o.y = pk2(s[2 * 36], s[3 * 36]); o.z = pk2(s[4 * 36], s[5 * 36]); o.w = pk2(s[6 * 36], s[7 * 36]);
        *(GAS v4u*)(WT + (size_t)(dst_row0 + n) * K + k0 + 8 * c) = o; }
    LDS_WAIT(); asm volatile("" ::: "memory");
}
DI void rms_row_to_bf16(const float* xrow, const float* gain, bf16* orow, int lane, unsigned char* o8 = nullptr, float* sa = nullptr) {
    f32x4 v[8]; float s = 0.f;
#pragma unroll
    for (int j = 0; j < 8; ++j) { v[j] = __builtin_nontemporal_load((const GAS f32x4*)(xrow + 4 * (lane + 64 * j))); s += (v[j].x * v[j].x + v[j].y * v[j].y) + (v[j].z * v[j].z + v[j].w * v[j].w); }
    const float rstd = 1.0f / sqrtf(wave_sum(s) * (1.0f / D) + EPS);
#pragma unroll
    for (int j = 0; j < 8; ++j) { const f32x4 g0 = *(const GAS f32x4*)(gain + 4 * (lane + 64 * j)); const f32x4 a = v[j] * rstd * g0; v[j] = a;
        __builtin_nontemporal_store(((v2u){pk2(a.x, a.y), pk2(a.z, a.w)}), (GAS v2u*)(orow + 4 * (lane + 64 * j))); }
    if (o8) { float mx = 0.f;
#pragma unroll
        for (int j = 0; j < 8; ++j) mx = fmaxf(fmaxf(mx, fmaxf(fabsf(v[j].x), fabsf(v[j].y))), fmaxf(fabsf(v[j].z), fabsf(v[j].w)));
        mx = wave_max(mx); const float inv = mx > 0.f ? 127.0f / mx : 0.f;
#pragma unroll
        for (int j = 0; j < 8; ++j) __builtin_nontemporal_store(pack_i8(v[j], inv), (GAS unsigned*)(o8 + 4 * (lane + 64 * j)));
        if (lane == 0) *sa = mx * (1.0f / 127.0f); }
}
DI void p0_colmax_item(const float* W, int ldw, int src_col0, unsigned* cmax, int dst_row0, int kb, int lane) {
    const int k0 = 64 * kb, kr = lane >> 3, nc = lane & 7;
    f32x4 mx = (f32x4){0.f, 0.f, 0.f, 0.f};
#pragma unroll
    for (int i = 0; i < 8; ++i) { const f32x4 v = *(const GAS f32x4*)(W + (size_t)(k0 + kr + 8 * i) * ldw + src_col0 + 4 * nc);
        mx.x = fmaxf(mx.x, fabsf(v.x)); mx.y = fmaxf(mx.y, fabsf(v.y)); mx.z = fmaxf(mx.z, fabsf(v.z)); mx.w = fmaxf(mx.w, fabsf(v.w)); }
#pragma unroll
    for (int o = 8; o < 64; o <<= 1) { mx.x = fmaxf(mx.x, __shfl_xor(mx.x, o)); mx.y = fmaxf(mx.y, __shfl_xor(mx.y, o)); mx.z = fmaxf(mx.z, __shfl_xor(mx.z, o)); mx.w = fmaxf(mx.w, __shfl_xor(mx.w, o)); }
    if (lane < 8) { unsigned* p = cmax + dst_row0 + 4 * nc;
        atomicMax(p, __float_as_uint(mx.x)); atomicMax(p + 1, __float_as_uint(mx.y)); atomicMax(p + 2, __float_as_uint(mx.z)); atomicMax(p + 3, __float_as_uint(mx.w)); }
}
DI void p0_transpose_i8_item(const float* W, int ldw, int K, int src_col0, signed char* WT, const unsigned* cmax, int dst_row0, LAS float* scr, int kb, int lane) {
    const int k0 = 64 * kb, kr = lane >> 3, nc = lane & 7;
    f32x4 v[8];
#pragma unroll
    for (int i = 0; i < 8; ++i) v[i] = *(const GAS f32x4*)(W + (size_t)(k0 + kr + 8 * i) * ldw + src_col0 + 4 * nc);
#pragma unroll
    for (int i = 0; i < 8; ++i) *(LAS f32x4*)(scr + (kr + 8 * i) * 36 + 4 * nc) = v[i];
    LDS_WAIT(); asm volatile("" ::: "memory");
    const int c = lane & 7;
#pragma unroll
    for (int j = 0; j < 4; ++j) { const int n = (lane >> 3) + 8 * j; const LAS float* s = scr + (8 * c) * 36 + n;
        const float cm = __uint_as_float(cmax[dst_row0 + n]), inv = cm > 0.f ? 127.0f / cm : 0.f;
        v2u o; o.x = pack_i8((f32x4){s[0 * 36], s[1 * 36], s[2 * 36], s[3 * 36]}, inv); o.y = pack_i8((f32x4){s[4 * 36], s[5 * 36], s[6 * 36], s[7 * 36]}, inv);
        *(GAS v2u*)(WT + (size_t)(dst_row0 + n) * K + k0 + 8 * c) = o; }
    LDS_WAIT(); asm volatile("" ::: "memory");
}
DI void p0_strip_i8(Frame& F, const float* W, int ldw, int src_col0, signed char* WT, float* sb, int dst_row0) {
    const int lane = F.lane, w = F.wave, kr = lane >> 3, nc = lane & 7;
    LAS float* scr = (LAS float*)(F.lds + w * 16384); LAS float* cmx = (LAS float*)(F.lds + 131072);
    f32x4 v[4][8];
    const unsigned off0 = (unsigned)((256 * w + kr) * ldw + src_col0 + 4 * nc) * 4u;
#pragma unroll
    for (int j = 0; j < 4; ++j)
#pragma unroll
        for (int i = 0; i < 8; ++i) v[j][i] = P0_LD((const GAS f32x4*)((const char*)W + (off0 + (unsigned)((64 * j + 8 * i) * ldw) * 4u)));
    f32x4 mx = (f32x4){0.f, 0.f, 0.f, 0.f};
#pragma unroll
    for (int j = 0; j < 4; ++j)
#pragma unroll
        for (int i = 0; i < 8; ++i) { mx.x = fmaxf(mx.x, fabsf(v[j][i].x)); mx.y = fmaxf(mx.y, fabsf(v[j][i].y)); mx.z = fmaxf(mx.z, fabsf(v[j][i].z)); mx.w = fmaxf(mx.w, fabsf(v[j][i].w)); }
#pragma unroll
    for (int o = 8; o < 64; o <<= 1) { mx.x = fmaxf(mx.x, __shfl_xor(mx.x, o)); mx.y = fmaxf(mx.y, __shfl_xor(mx.y, o)); mx.z = fmaxf(mx.z, __shfl_xor(mx.z, o)); mx.w = fmaxf(mx.w, __shfl_xor(mx.w, o)); }
    if (lane < 8) *(LAS f32x4*)(cmx + w * 32 + 4 * nc) = mx;
    __syncthreads();
    float inv[4];
#pragma unroll
    for (int j = 0; j < 4; ++j) { const int n = (lane >> 3) + 8 * j; float cm = 0.f;
#pragma unroll
        for (int ww = 0; ww < 8; ++ww) cm = fmaxf(cm, cmx[ww * 32 + n]);
        inv[j] = cm > 0.f ? 127.0f / cm : 0.f;
        if (w == 0 && (lane & 7) == 0) sb[dst_row0 + n] = cm * (1.0f / 127.0f); }
    const int c = lane & 7;
#pragma unroll
    for (int j4 = 0; j4 < 4; ++j4) {
#pragma unroll
        for (int i = 0; i < 8; ++i) *(LAS f32x4*)(scr + (kr + 8 * i) * 36 + 4 * nc) = v[j4][i];
        LDS_WAIT(); asm volatile("" ::: "memory");
#pragma unroll
        for (int j = 0; j < 4; ++j) { const int n = (lane >> 3) + 8 * j; const LAS float* sp = scr + (8 * c) * 36 + n;
            v2u o; o.x = pack_i8((f32x4){sp[0 * 36], sp[1 * 36], sp[2 * 36], sp[3 * 36]}, inv[j]); o.y = pack_i8((f32x4){sp[4 * 36], sp[5 * 36], sp[6 * 36], sp[7 * 36]}, inv[j]);
            *(GAS v2u*)((char*)WT + (unsigned)((dst_row0 + n) * D + 256 * w + 64 * j4 + 8 * c)) = o; }
        LDS_WAIT(); asm volatile("" ::: "memory"); }
    __syncthreads();
}
DI void p0_weights(Frame& F, int l) {
    for (int sidx = F.bid; sidx < NUP / 32 + NI8 / 32; sidx += F.G) {
        if (sidx < NUP / 32) { const int n0 = 32 * sidx, cc = n0 >= DFF ? n0 - DFF : n0, drow = (cc >> 7) * 256 + (n0 >= DFF ? 128 : 0) + (cc & 127);
            p0_strip_i8(F, F.in[23] + (size_t)l * D * NUP, NUP, n0, (signed char*)(F.ws + WS_WUP), (float*)(F.ws + T_SB_UP), drow); }
        else { const int r8 = 32 * (sidx - NUP / 32);
            int n0 = r8 < 2048 ? r8 + 2048 : r8 + 4096;
            if (r8 >= 4096 && r8 < 8192) { const int q = r8 - 4096, ww = q & 255; n0 = C_GATE + (ww >> 7) * 2048 + 128 * (q >> 8) + (ww & 127); }
            const int oc = n0 < 4096 ? n0 : n0 + 8;
            p0_strip_i8(F, F.in[5] + (size_t)l * D * NIN, NIN, oc, (signed char*)(F.ws + WS_WG8), (float*)(F.ws + T_SB_G), r8); }
    }
    LAS float* scr = (LAS float*)(F.lds + F.wave * 16384);
    const int gw = F.bid * NWAVES + F.wave, NGW = F.G * NWAVES;
    constexpr int I_IN = 32 * 128, I_GLU = 16 * 64, I_B = 3 * 16 * 64, I_OUT = 32 * 64, I_DN = 88 * 64, I_LAYER = I_IN + I_GLU + I_B + I_OUT + I_DN;
    for (int it = gw; it < I_LAYER; it += NGW) {
        int r = it;
        if (r < I_IN) { const int kb = r / 128, nb = r % 128, nd = 32 * nb, n0 = nd < 2048 ? nd : nd + 2048;
            const int oc = n0 < 4096 ? n0 : n0 + 8;
            p0_transpose_item(F.in[5] + (size_t)l * D * NIN, NIN, D, oc, (bf16*)(F.ws + WS_WIN), nd, scr, kb, F.lane);
            continue; } r -= I_IN;
        if (r < I_GLU) { const int kb = r / 64, nb = r % 64, n0 = 32 * nb; const int cc = n0 & 1023, drow = (cc >> 7) * 256 + (n0 >= 1024 ? 128 : 0) + (cc & 127);
            p0_transpose_item(F.in[20] + (size_t)l * 1024 * 2048, 2048, 1024, n0, (bf16*)(F.ws + WS_WGLU), drow, scr, kb, F.lane); continue; } r -= I_GLU;
        if (r < I_B) { const int n = r / 1024, rr = r % 1024, kb = rr / 64, nb = rr % 64;
            p0_transpose_item(F.in[21] + (size_t)(l * 3 + n) * 1024 * 2048, 2048, 1024, 32 * nb, (bf16*)(F.ws + WS_WB) + (size_t)n * 2048 * 1024, 32 * nb, scr, kb, F.lane); continue; } r -= I_B;
        if (r < I_OUT) { const int kb = r / 64, nb = r % 64;
            p0_transpose_item(F.in[22] + (size_t)l * D * D, D, D, 32 * nb, (bf16*)(F.ws + WS_WOUT), 32 * nb, scr, kb, F.lane); continue; } r -= I_OUT;
        { const int kb = r / 64, nb = r % 64;
            p0_transpose_item(F.in[26] + (size_t)l * DFF * D, D, DFF, 32 * nb, (bf16*)(F.ws + WS_WDN), 32 * nb, scr, kb, F.lane); }
    }
}
DI void p0_tables(Frame& F) {
    const int gw = F.bid * NWAVES + F.wave, NGW = F.G * NWAVES;
    const int gt = F.bid * NTHR + F.tid, NGT = F.G * NTHR;
    if (gt < 4) ((unsigned*)(F.ws + T_ONES))[gt] = 0x3F803F80u;
    if (gw < DEPTH) { const int lane = F.lane; const float* lam = F.in[9] + gw * 4 * 128;
        const float s01 = wave_sum(lam[lane] * lam[128 + lane] + lam[64 + lane] * lam[192 + lane]);
        const float s23 = wave_sum(lam[256 + lane] * lam[384 + lane] + lam[320 + lane] * lam[448 + lane]);
        const float lambda_init = 0.8f - 0.6f * expf(-0.3f * (float)gw);
        if (lane == 0) { ((float*)(F.ws + T_LAM))[2 * gw] = expf(s01) - expf(s23) + lambda_init; ((float*)(F.ws + T_LAM))[2 * gw + 1] = 1.0f - lambda_init; } }
    for (int i = gt; i < DEPTH * 8 * D; i += NGT) { const int l = i / (8 * D), j = (i / D) & 7, d = i % D;
        ((float*)(F.ws + T_WIF))[i] = F.in[5][((size_t)l * D + d) * NIN + 4096 + j]; }
    for (int i = gt; i < 4 * 128; i += NGT) { const int h = i >> 7, n = i & 127;
        int bk = n; if (n >= 16) { bk = 16 + (int)(logf((float)n / 16.0f) / 2.0794415416798357f * 16.0f); bk = bk < 31 ? bk : 31; }
        ((float*)(F.ws + T_BIAS))[i] = F.in[11][bk * 4 + h] * 1.4426950409f; }
    for (int i = gt; i < DEPTH * 64 * 64; i += NGT) {
        const int l = i >> 12, g = (i >> 6) & 63, p = i & 63;
        const float lr = F.in[12][i], li = F.in[13][i], dt = expf(F.in[14][l * 64 + g]);
        const float mag = expf(lr * dt), are = mag * cosf(li * dt), aim = mag * sinf(li * dt), den = lr * lr + li * li;
        const float zre = ((are - 1.0f) * lr + aim * li) / den, zim = (aim * lr - (are - 1.0f) * li) / den;
        ((float*)(F.ws + T_S5A))[2 * i] = are; ((float*)(F.ws + T_S5A))[2 * i + 1] = aim;
        bf16* bbt = (bf16*)(F.ws + T_BBT) + ((size_t)(l * 64 + g) * 128 + 2 * p) * 16;
        bf16* ct = (bf16*)(F.ws + T_CT) + (size_t)(l * 64 + g) * 16 * 128;
        for (int c = 0; c < 16; ++c) { const float br = F.in[15][(size_t)i * 16 + c], bi = F.in[16][(size_t)i * 16 + c];
            bbt[c] = (bf16)f2bf(zre * br - zim * bi); bbt[16 + c] = (bf16)f2bf(zre * bi + zim * br);
            const size_t ci = ((size_t)(l * 64 + g) * 16 + c) * 64 + p;
            ct[c * 128 + 2 * p] = (bf16)f2bf(F.in[17][ci]); ct[c * 128 + 2 * p + 1] = (bf16)f2bf(-F.in[18][ci]); }
    }
    for (int m = gw; m < M; m += NGW) rms_row_to_bf16(F.in[0] + (size_t)m * D, F.in[1], (bf16*)(F.ws + WS_XN) + (size_t)m * D, F.lane, F.ws + WS_XN8M + (size_t)m * D, (float*)(F.ws + T_SA_MIX) + m);
}

DI void p2_conv_gates(Frame& F, int layer, int chunk) {
    const bf16* proj = (const bf16*)(F.ws + WS_PROJ); bf16* qkc = (bf16*)(F.ws + WS_QKC);
    const float* cw = F.in[7] + (size_t)layer * 4 * 2048;
    LAS float* wl = (LAS float*)F.lds;
    { const float* wif = (const float*)(F.ws + T_WIF) + (size_t)layer * 8 * D;
      for (int i = F.tid; i < 8 * D / 4; i += NTHR) ((LAS f32x4*)wl)[i] = ((const GAS f32x4*)wif)[i]; }
    const int gt = F.bid * NTHR + F.tid, NGT = F.G * NTHR;
    for (int task = gt; task < 1024 * 256; task += NGT) {
        const int cp = task & 1023, run = task >> 10, r0 = run * 32, t0 = r0 & (L - 1), c = 2 * cp;
        float w0[4], w1[4];
#pragma unroll
        for (int j = 0; j < 4; ++j) { w0[j] = ((const GAS float*)cw)[j * 2048 + c]; w1[j] = ((const GAS float*)cw)[j * 2048 + c + 1]; }
        const float post = c >= 1024 ? 0.0625f : 1.0f;
        float a0[3], a1[3];
#pragma unroll
        for (int j = 0; j < 3; ++j) { unsigned w = 0u; if (t0 > 0) w = *(const GAS unsigned*)(proj + (size_t)(r0 - 3 + j) * NP + c); a0[j] = bflo(w); a1[j] = bfhi(w); }
        unsigned w8[8], wn[8];
#pragma unroll
        for (int u = 0; u < 8; ++u) w8[u] = *(const GAS unsigned*)(proj + (size_t)(r0 + u) * NP + c);
#pragma unroll
        for (int tb = 0; tb < 32; tb += 8) {
          if (tb + 8 < 32) {
#pragma unroll
            for (int u = 0; u < 8; ++u) wn[u] = *(const GAS unsigned*)(proj + (size_t)(r0 + tb + 8 + u) * NP + c); }
#pragma unroll
          for (int u = 0; u < 8; ++u) { const int t = tb + u;
            const unsigned w = w8[u]; const float x0 = bflo(w), x1 = bfhi(w);
            float y0 = w0[0] * a0[0] + w0[1] * a0[1] + w0[2] * a0[2] + w0[3] * x0, y1 = w1[0] * a1[0] + w1[1] * a1[1] + w1[2] * a1[2] + w1[3] * x1;
            y0 = y0 * sigm(y0) * post; y1 = y1 * sigm(y1) * post;
            *(GAS unsigned*)(qkc + (size_t)(r0 + t) * 2048 + c) = pk2(y0, y1);
            a0[0] = a0[1]; a0[1] = a0[2]; a0[2] = x0; a1[0] = a1[1]; a1[1] = a1[2]; a1[2] = x1;
          }
#pragma unroll
          for (int u = 0; u < 8; ++u) w8[u] = wn[u];
        }
    }
    __syncthreads();
    const bf16* xn = (const bf16*)(F.ws + WS_XN) + (size_t)chunk * MC * D; float* ifg = (float*)(F.ws + WS_IFG) + (size_t)chunk * MC * 8;
    const float* bif = F.in[6] + layer * 8;
    const int gw = F.bid * NWAVES + F.wave, NGW = F.G * NWAVES;
    for (int r = gw; r < MC; r += NGW) {
        float x[32];
#pragma unroll
        for (int j = 0; j < 4; ++j) { const v4u w = *(const GAS v4u*)(xn + (size_t)r * D + 8 * (F.lane + 64 * j));
            x[8 * j] = bflo(w.x); x[8 * j + 1] = bfhi(w.x); x[8 * j + 2] = bflo(w.y); x[8 * j + 3] = bfhi(w.y); x[8 * j + 4] = bflo(w.z); x[8 * j + 5] = bfhi(w.z); x[8 * j + 6] = bflo(w.w); x[8 * j + 7] = bfhi(w.w); }
        float res = 0.f;
#pragma unroll 1
        for (int jg = 0; jg < 8; ++jg) { float s = 0.f;
#pragma unroll
            for (int j = 0; j < 4; ++j) { const f32x4 wa = *(const LAS f32x4*)(wl + jg * D + 8 * (F.lane + 64 * j)), wb = *(const LAS f32x4*)(wl + jg * D + 8 * (F.lane + 64 * j) + 4);
                s += x[8 * j] * wa.x + x[8 * j + 1] * wa.y + x[8 * j + 2] * wa.z + x[8 * j + 3] * wa.w + x[8 * j + 4] * wb.x + x[8 * j + 5] * wb.y + x[8 * j + 6] * wb.z + x[8 * j + 7] * wb.w; }
            s = wave_sum(s); if (F.lane == jg) res = s + ((const GAS float*)bif)[jg]; }
        if (F.lane < 8) ((GAS float*)ifg)[(size_t)r * 8 + F.lane] = res;
    }
    __syncthreads();
}

constexpr int ML_QS = 0, ML_KS = 33792, ML_VX = 67584, ML_VW = 77824, ML_SS = 88064, ML_CT = 97280, ML_GT = 139520;
constexpr int ML_P = 528, ML_VP = 160, ML_SP = 144;
DI void mlstm_item(Frame& F, int chunk, int item) {
    const int bl = item >> 4, h = (item >> 2) & 3, sl = item & 3;
    const int lrow0 = bl * L; const size_t grow0 = (size_t)chunk * MC + lrow0;
    const bf16* proj = (const bf16*)(F.ws + WS_PROJ); const bf16* qkc = (const bf16*)(F.ws + WS_QKC); const float* ifg = (const float*)(F.ws + WS_IFG);
    bf16* hm = (bf16*)(F.ws + WS_HM);
    LAS unsigned char* lds = F.lds;
    LAS float* gd = (LAS float*)(lds + ML_GT); LAS float* gM = gd + 64; LAS float* gwt = gd + 128; LAS float* gem = gd + 192;
    const int tid = F.tid, lane = F.lane, w = F.wave, fr = lane & 15, fq = lane >> 4, q4 = fr >> 2, p4 = fr & 3;
    constexpr float LOG2E = 1.4426950408889634f, LN2 = 0.6931471805599453f;
    { unsigned z0 = 0u; asm volatile("" : "+v"(z0));
      for (int i = tid; i < 42240 / 16; i += NTHR) ((LAS v4u*)(lds + ML_CT))[i] = (v4u){z0, z0, z0, z0}; }
    f32x4 Cacc[5][2];
#pragma unroll
    for (int a = 0; a < 5; ++a)
#pragma unroll
        for (int b = 0; b < 2; ++b) Cacc[a][b] = (f32x4){0.f, 0.f, 0.f, 0.f};
    float m_prev = 0.f;
    v4u rq[4], rk[4], rv; float ripre, rfpre;
#define ML_LOAD_KV(t0_) do { ripre = ((const GAS float*)ifg)[(grow0 + (t0_) + lane) * 8 + h]; rfpre = ((const GAS float*)ifg)[(grow0 + (t0_) + lane) * 8 + 4 + h]; \
        _Pragma("unroll") for (int i = 0; i < 4; ++i) { const int q = tid + NTHR * i, s = q >> 5, c16 = q & 31; rk[i] = *(const GAS v4u*)(qkc + (size_t)(lrow0 + (t0_) + s) * 2048 + 1024 + h * 256 + 8 * c16); } \
        { const int s = tid >> 3, c8 = tid & 7; rv = *(const GAS v4u*)(proj + (size_t)(lrow0 + (t0_) + s) * NP + C_VM + h * 256 + sl * 64 + 8 * c8); } } while (0)
#define ML_LOAD_Q(t0_) do { _Pragma("unroll") for (int i = 0; i < 4; ++i) { const int q = tid + NTHR * i, s = q >> 5, c16 = q & 31; rq[i] = *(const GAS v4u*)(qkc + (size_t)(lrow0 + (t0_) + s) * 2048 + h * 256 + 8 * c16); } } while (0)
    ML_LOAD_KV(0); ML_LOAD_Q(0);
    for (int c = 0; c < L / 64; ++c) {
        const int t0 = 64 * c;
        const float ipre = ripre, fpre = rfpre;
        const float lf = fminf(fpre, 0.f) - LN2 * __builtin_amdgcn_logf(1.0f + ex2(-LOG2E * fabsf(fpre)));
        float b = lf;
#pragma unroll
        for (int o = 1; o < 64; o <<= 1) { const float v = __shfl_up(b, o); if (lane >= o) b += v; }
        const float dd = ipre - b; float pm = dd;
#pragma unroll
        for (int o = 1; o < 64; o <<= 1) { const float v = __shfl_up(pm, o); if (lane >= o) pm = fmaxf(pm, v); }
        const float Mt = fmaxf(m_prev, pm), wt = ex2(LOG2E * (m_prev - Mt)), em = ex2(-LOG2E * (b + Mt));
        const float M63 = __shfl(Mt, 63), g = __shfl(b, 63), wsv = ex2(LOG2E * (dd - M63)), decay = ex2(LOG2E * (m_prev - M63));
        if (w == 0) { gd[lane] = dd * LOG2E; gM[lane] = Mt * LOG2E; gwt[lane] = wt; gem[lane] = em; }
#pragma unroll
        for (int i = 0; i < 4; ++i) { const int q = tid + NTHR * i, s = q >> 5, c16 = q & 31;
            *(LAS v4u*)(lds + ML_QS + s * ML_P + 16 * c16) = rq[i]; *(LAS v4u*)(lds + ML_KS + s * ML_P + 16 * c16) = rk[i]; }
        { const int s = tid >> 3, c8 = tid & 7; const float wss = __shfl(wsv, s & 63);
          const v4u v = rv;
          *(LAS v4u*)(lds + ML_VX + s * ML_VP + 16 * c8) = v;
          v4u o; o.x = pk2(bflo(v.x) * wss, bfhi(v.x) * wss); o.y = pk2(bflo(v.y) * wss, bfhi(v.y) * wss); o.z = pk2(bflo(v.z) * wss, bfhi(v.z) * wss); o.w = pk2(bflo(v.w) * wss, bfhi(v.w) * wss);
          *(LAS v4u*)(lds + ML_VW + s * ML_VP + 16 * c8) = o; }
        if (w == 0) { const int s = lane; unsigned z = 0u; asm volatile("" : "+v"(z));
            *(LAS v4u*)(lds + ML_VX + s * ML_VP + 128) = (v4u){0x3F80u | z, z, z, z}; *(LAS v4u*)(lds + ML_VX + s * ML_VP + 144) = (v4u){z, z, z, z};
            *(LAS v4u*)(lds + ML_VW + s * ML_VP + 128) = (v4u){pk2(wsv, 0.f), z, z, z}; *(LAS v4u*)(lds + ML_VW + s * ML_VP + 144) = (v4u){z, z, z, z}; }
        if (c + 1 < L / 64) ML_LOAD_KV(t0 + 64);
        __syncthreads();
        { const int tb = w >> 1, sb0 = 2 * (w & 1);
          if (sb0 <= tb) {
            const bool two = (sb0 + 1) <= tb;
            const float mt = gM[16 * tb + fr];
            const f32x4 d0 = *(const LAS f32x4*)(gd + 16 * sb0 + 4 * fq), d1 = *(const LAS f32x4*)(gd + 16 * (sb0 + 1) + 4 * fq);
            f32x4 a0 = (f32x4){0.f, 0.f, 0.f, 0.f}, a1 = a0;
#pragma unroll
            for (int hk = 0; hk < 2; ++hk) {
                bf16x8 qa[4], ka[4], kc[4];
#pragma unroll
                for (int k4 = 0; k4 < 4; ++k4) { const int ks = 4 * hk + k4;
                    qa[k4] = *(const LAS bf16x8*)(lds + ML_QS + (16 * tb + fr) * ML_P + (32 * ks + 8 * fq) * 2);
                    ka[k4] = *(const LAS bf16x8*)(lds + ML_KS + (16 * sb0 + fr) * ML_P + (32 * ks + 8 * fq) * 2);
                    kc[k4] = *(const LAS bf16x8*)(lds + ML_KS + (16 * (sb0 + 1) + fr) * ML_P + (32 * ks + 8 * fq) * 2); }
                SB1();
#pragma unroll
                for (int k4 = 0; k4 < 4; ++k4) { a0 = MFMA16(ka[k4], qa[k4], a0); a1 = MFMA16(kc[k4], qa[k4], a1); }
                SB1(); }
            const int t = 16 * tb + fr;
            { const int s0 = 16 * sb0 + 4 * fq; float v[4];
#pragma unroll
              for (int i = 0; i < 4; ++i) v[i] = (s0 + i <= t) ? a0[i] * ex2(d0[i] - mt) : 0.f;
              *(LAS v2u*)(lds + ML_SS + t * ML_SP + 2 * s0) = (v2u){pk2(v[0], v[1]), pk2(v[2], v[3])}; }
            { const int s0 = 16 * (sb0 + 1) + 4 * fq; float v[4];
#pragma unroll
              for (int i = 0; i < 4; ++i) v[i] = (two && s0 + i <= t) ? a1[i] * ex2(d1[i] - mt) : 0.f;
              *(LAS v2u*)(lds + ML_SS + t * ML_SP + 2 * s0) = (v2u){pk2(v[0], v[1]), pk2(v[2], v[3])}; }
          } else {
            const int t = 16 * tb + fr;
            *(LAS v2u*)(lds + ML_SS + t * ML_SP + 2 * (16 * sb0 + 4 * fq)) = (v2u){0u, 0u}; *(LAS v2u*)(lds + ML_SS + t * ML_SP + 2 * (16 * (sb0 + 1) + 4 * fq)) = (v2u){0u, 0u};
          } }
        __syncthreads();
        { const int tb = w & 3, half = w >> 2, t = 16 * tb + fr;
          bf16x8 qf[8], sf[2], ca[8], vx[2];
          f32x4 qc[3], sv[3];
#pragma unroll
          for (int ks = 0; ks < 8; ++ks) qf[ks] = *(const LAS bf16x8*)(lds + ML_QS + t * ML_P + (32 * ks + 8 * fq) * 2);
#pragma unroll
          for (int ks = 0; ks < 2; ++ks) sf[ks] = *(const LAS bf16x8*)(lds + ML_SS + t * ML_SP + (32 * ks + 8 * fq) * 2);
          const float wt_t = gwt[t], em_t = gem[t];
#pragma unroll
          for (int j = 0; j < 3; ++j) { const int vb = (j == 2) ? 4 : (2 * half + j);
#pragma unroll
              for (int ks = 0; ks < 8; ++ks) ca[ks] = *(const LAS bf16x8*)(lds + ML_CT + (16 * vb + fr) * ML_P + (32 * ks + 8 * fq) * 2);
#pragma unroll
              for (int ks = 0; ks < 2; ++ks) { const LAS unsigned char* p0 = lds + ML_VX + (32 * ks + 8 * fq + q4) * ML_VP + (16 * vb + 4 * p4) * 2; vx[ks] = tr8(p0, p0 + 4 * ML_VP); }
              SB2();
              f32x4 a = (f32x4){0.f, 0.f, 0.f, 0.f}, b2 = a;
#pragma unroll
              for (int ks = 0; ks < 2; ++ks) b2 = MFMA16(vx[ks], sf[ks], b2);
#pragma unroll
              for (int ks = 0; ks < 8; ++ks) a = MFMA16(ca[ks], qf[ks], a);
              qc[j] = a; sv[j] = b2;
              SB2(); }
          const float den = __shfl(wt_t * qc[2][0] + sv[2][0], fr);
          const float inv = __builtin_amdgcn_rcpf(fmaxf(fabsf(den), em_t));
#pragma unroll
          for (int j = 0; j < 2; ++j) { const int vb = 2 * half + j; float o[4];
#pragma unroll
              for (int i = 0; i < 4; ++i) o[i] = (wt_t * qc[j][i] + sv[j][i]) * inv;
              *(GAS v2u*)(hm + (size_t)(lrow0 + t0 + t) * 1024 + h * 256 + sl * 64 + 16 * vb + 4 * fq) = (v2u){pk2(o[0], o[1]), pk2(o[2], o[3])}; } }
        __syncthreads();
        if (c + 1 < L / 64) ML_LOAD_Q(t0 + 64);
        { bf16x8 kf[2][2], vf[5][2];
#pragma unroll
          for (int dbi = 0; dbi < 2; ++dbi)
#pragma unroll
            for (int ks = 0; ks < 2; ++ks) { const LAS unsigned char* p0 = lds + ML_KS + (32 * ks + 8 * fq + q4) * ML_P + (16 * (2 * w + dbi) + 4 * p4) * 2; kf[dbi][ks] = tr8(p0, p0 + 4 * ML_P); }
#pragma unroll
          for (int vb = 0; vb < 5; ++vb)
#pragma unroll
            for (int ks = 0; ks < 2; ++ks) { const LAS unsigned char* p0 = lds + ML_VW + (32 * ks + 8 * fq + q4) * ML_VP + (16 * vb + 4 * p4) * 2; vf[vb][ks] = tr8(p0, p0 + 4 * ML_VP); }
#pragma unroll
          for (int vb = 0; vb < 5; ++vb)
#pragma unroll
            for (int dbi = 0; dbi < 2; ++dbi) Cacc[vb][dbi] = Cacc[vb][dbi] * decay;
          SB3();
#pragma unroll
          for (int ks = 0; ks < 2; ++ks)
#pragma unroll
            for (int vb = 0; vb < 5; ++vb)
#pragma unroll
              for (int dbi = 0; dbi < 2; ++dbi) Cacc[vb][dbi] = MFMA16(kf[dbi][ks], vf[vb][ks], Cacc[vb][dbi]);
          SB3();
#pragma unroll
          for (int vb = 0; vb < 5; ++vb)
#pragma unroll
            for (int dbi = 0; dbi < 2; ++dbi) { const f32x4 a = Cacc[vb][dbi];
                *(LAS v2u*)(lds + ML_CT + (16 * vb + fr) * ML_P + (16 * (2 * w + dbi) + 4 * fq) * 2) = (v2u){pk2(a[0], a[1]), pk2(a[2], a[3])}; } }
        m_prev = g + M63;
        __syncthreads();
    }
#undef ML_LOAD_KV
#undef ML_LOAD_Q
}

constexpr int AT_KB = 0, AT_VB = 69632, AT_TBL = 139264, AT_KP = 272, AT_VP = 544, AT_KBUF = 17408, AT_VBUF = 34816, AT_XP = 1040;
DI void attn_item(Frame& F, int layer, int item) {
    const int qi = 31 - (item >> 4), r4 = item & 15, bl = r4 >> 2, h = r4 & 3;
    const int lrow0 = bl * L;
    const bf16* proj = (const bf16*)(F.ws + WS_PROJ); bf16* Y = (bf16*)(F.ws + WS_Y);
    LAS unsigned char* lds = F.lds; LAS float* tbl = (LAS float*)(lds + AT_TBL);
    const int tid = F.tid, lane = F.lane, w = F.wave, map = w >> 2, wq = w & 3, fr = lane & 15, fq = lane >> 4, q4 = fr >> 2, p4 = fr & 3;
    if (tid < 128) tbl[tid] = ((const GAS float*)(F.ws + T_BIAS))[h * 128 + tid];
    else if (tid < 384) tbl[tid] = ((const GAS float*)F.in[10])[layer * 1024 + h * 256 + tid - 128];
    const float lam_full = ((const GAS float*)(F.ws + T_LAM))[2 * layer], post = ((const GAS float*)(F.ws + T_LAM))[2 * layer + 1];
    const int r0 = 64 * qi + 16 * wq;
    bf16x8 qf[4];
    { const bf16* qp = proj + (size_t)(lrow0 + r0 + fr) * NP + C_QD + h * 256 + map * 128 + 8 * fq;
#pragma unroll
      for (int ks = 0; ks < 4; ++ks) qf[ks] = *(const GAS bf16x8*)(qp + 32 * ks); }
    const bf16* kbase = proj + (size_t)lrow0 * NP + C_KD + h * 256;
    const bf16* vbase = proj + (size_t)lrow0 * NP + C_VD + h * 256;
    const int nkt = qi + 1;
    f32x4 O[16];
#pragma unroll
    for (int i = 0; i < 16; ++i) O[i] = (f32x4){0.f, 0.f, 0.f, 0.f};
    float mrun = -INFINITY, lsum = 0.f;
    const float sc2 = 0.08838834764831845f * 1.4426950408889634f;
    v4u kreg[4], vreg[4];
#define AT_LOAD(kt) do { _Pragma("unroll") for (int i = 0; i < 4; ++i) { const int q = tid + NTHR * i, row = q >> 5, c16 = q & 31; kreg[i] = *(const GAS v4u*)(kbase + (size_t)(64 * (kt) + row) * NP + 8 * c16); } \
        _Pragma("unroll") for (int i = 0; i < 4; ++i) { const int q = tid + NTHR * i, row = q >> 5, c16 = q & 31; vreg[i] = *(const GAS v4u*)(vbase + (size_t)(64 * (kt) + row) * NP + 8 * c16); } } while (0)
#define AT_STORE(buf) do { _Pragma("unroll") for (int i = 0; i < 4; ++i) { const int q = tid + NTHR * i, row = q >> 5, c16 = q & 31; *(LAS v4u*)(lds + AT_KB + ((c16 >> 4) * 2 + (buf)) * AT_KBUF + row * AT_KP + 16 * (c16 & 15)) = kreg[i]; } \
        _Pragma("unroll") for (int i = 0; i < 4; ++i) { const int q = tid + NTHR * i, row = q >> 5, c16 = q & 31; *(LAS v4u*)(lds + AT_VB + (buf) * AT_VBUF + row * AT_VP + 16 * c16) = vreg[i]; } } while (0)
    AT_LOAD(0); AT_STORE(0);
    __syncthreads();
    for (int kt = 0; kt < nkt; ++kt) {
        const int buf = kt & 1, k0 = 64 * kt;
        if (kt + 1 < nkt) AT_LOAD(kt + 1);
        {
            const LAS unsigned char* kb_ = lds + AT_KB + (map * 2 + buf) * AT_KBUF; const LAS unsigned char* vb_ = lds + AT_VB + buf * AT_VBUF;
            f32x4 s[4];
            { bf16x8 kf[16];
#pragma unroll
              for (int kb = 0; kb < 4; ++kb)
#pragma unroll
                for (int ks = 0; ks < 4; ++ks) kf[4 * kb + ks] = *(const LAS bf16x8*)(kb_ + (16 * kb + fr) * AT_KP + (32 * ks + 8 * fq) * 2);
              SB();
#pragma unroll
              for (int kb = 0; kb < 4; ++kb) s[kb] = (f32x4){0.f, 0.f, 0.f, 0.f};
#pragma unroll
              for (int ks = 0; ks < 4; ++ks)
#pragma unroll
                for (int kb = 0; kb < 4; ++kb) s[kb] = MFMA16(kf[4 * kb + ks], qf[ks], s[kb]);
              SB(); }
            const int qpos = r0 + fr; const bool far = (r0 - (k0 + 63)) >= 113; const float bfar = tbl[127];
            float mx = -INFINITY;
            if (far) {
#pragma unroll
                for (int kb = 0; kb < 4; ++kb)
#pragma unroll
                    for (int i = 0; i < 4; ++i) { const float v = s[kb][i] * sc2 + bfar; s[kb][i] = v; mx = fmaxf(mx, v); }
            } else {
#pragma unroll
                for (int kb = 0; kb < 4; ++kb)
#pragma unroll
                    for (int i = 0; i < 4; ++i) { const int kpos = k0 + 16 * kb + 4 * fq + i, dist = qpos - kpos;
                        const float bias = tbl[dist < 0 ? 0 : (dist > 127 ? 127 : dist)];
                        float v = s[kb][i] * sc2 + bias; if (dist < 0) v = -INFINITY; s[kb][i] = v; mx = fmaxf(mx, v); }
            }
            mx = fmaxf(mx, __shfl_xor(mx, 16)); mx = fmaxf(mx, __shfl_xor(mx, 32));
            const float mnew = fmaxf(mrun, mx), alpha = ex2(mrun - mnew);
            const bool grow = __any(mnew > mrun);
            mrun = mnew;
            float ps = 0.f;
#pragma unroll
            for (int kb = 0; kb < 4; ++kb)
#pragma unroll
                for (int i = 0; i < 4; ++i) { const float p = ex2(s[kb][i] - mnew); s[kb][i] = p; ps += p; }
            lsum = lsum * alpha + ps;
            if (grow) {
#pragma unroll
                for (int i = 0; i < 16; ++i) O[i] = O[i] * alpha;
            }
            bf16x8 pb[2];
#pragma unroll
            for (int k2 = 0; k2 < 2; ++k2) { v4u t; t.x = pk2(s[2 * k2][0], s[2 * k2][1]); t.y = pk2(s[2 * k2][2], s[2 * k2][3]); t.z = pk2(s[2 * k2 + 1][0], s[2 * k2 + 1][1]); t.w = pk2(s[2 * k2 + 1][2], s[2 * k2 + 1][3]);
                pb[k2] = __builtin_bit_cast(bf16x8, t); }
            bf16x8 vfa[8], vfb[8];
#define AT_VLOAD(dst, b) do { _Pragma("unroll") for (int j = 0; j < 4; ++j) _Pragma("unroll") for (int k2 = 0; k2 < 2; ++k2) { \
                const LAS unsigned char* p0 = vb_ + (32 * k2 + 4 * fq + q4) * AT_VP + (16 * (4 * (b) + j) + 4 * p4) * 2; dst[2 * j + k2] = tr8(p0, p0 + 16 * AT_VP); } } while (0)
#define AT_VMMA(src, b) do { _Pragma("unroll") for (int j = 0; j < 4; ++j) _Pragma("unroll") for (int k2 = 0; k2 < 2; ++k2) O[4 * (b) + j] = MFMA16(src[2 * j + k2], pb[k2], O[4 * (b) + j]); } while (0)
            AT_VLOAD(vfa, 0); SB();
            AT_VLOAD(vfb, 1); SB(); AT_VMMA(vfa, 0); SB();
            AT_VLOAD(vfa, 2); SB(); AT_VMMA(vfb, 1); SB();
            AT_VLOAD(vfb, 3); SB(); AT_VMMA(vfa, 2); SB();
            AT_VMMA(vfb, 3); SB();
#undef AT_VLOAD
#undef AT_VMMA
        }
        if (kt + 1 < nkt) AT_STORE(buf ^ 1);
        __syncthreads();
    }
#undef AT_LOAD
#undef AT_STORE
    lsum += __shfl_xor(lsum, 16); lsum += __shfl_xor(lsum, 32);
    const float inv = 1.0f / lsum;
    LAS unsigned char* xo = lds + (16 * wq + fr) * AT_XP + 16 * fq;
    if (map == 1) {
#pragma unroll
        for (int vb = 0; vb < 16; ++vb) *(LAS f32x4*)(xo + 64 * vb) = O[vb] * inv; }
    __syncthreads();
    if (map == 0) {
        float ss = 0.f;
#pragma unroll
        for (int vb = 0; vb < 16; ++vb) { const f32x4 o2 = *(const LAS f32x4*)(xo + 64 * vb); const f32x4 d = O[vb] * inv - o2 * lam_full; O[vb] = d;
            ss += (d.x * d.x + d.y * d.y) + (d.z * d.z + d.w * d.w); }
        ss += __shfl_xor(ss, 16); ss += __shfl_xor(ss, 32);
        const float rstd = post / sqrtf(ss * (1.0f / 256.0f) + EPS);
        const LAS float* gdn = tbl + 128 + 4 * fq;
        bf16* yp = Y + (size_t)MC * 1024 + (size_t)(lrow0 + r0 + fr) * 1024 + h * 256 + 4 * fq;
#pragma unroll
        for (int vb = 0; vb < 16; ++vb) { const f32x4 g = *(const LAS f32x4*)(gdn + 16 * vb); const f32x4 o = O[vb] * rstd * g;
            *(GAS v2u*)(yp + 16 * vb) = (v2u){pk2(o.x, o.y), pk2(o.z, o.w)}; }
    }
}

constexpr int S5_WB = 12800, S5_BUP = 528, S5_XO = 8448, S5_XP = 272;
DI void s5_item(Frame& F, int layer, int item) {
    const int bl = item >> 3, g = (item & 7) * 8 + F.wave, lrow0 = bl * L;
    const bf16* proj = (const bf16*)(F.ws + WS_PROJ); bf16* ys5 = (bf16*)(F.ws + WS_YS5);
    LAS unsigned char* bu = F.lds + F.wave * S5_WB; LAS unsigned char* xs = bu + S5_XO;
    const int lane = F.lane, fr = lane & 15, fq = lane >> 4;
    const int lg = layer * 64 + g;
    bf16x8 bbf[8], ctf[4];
    const bf16x8 zf = (bf16x8){0, 0, 0, 0, 0, 0, 0, 0};
#pragma unroll
    for (int nb = 0; nb < 8; ++nb) { bbf[nb] = zf; if (fq < 2) bbf[nb] = *(const GAS bf16x8*)((const bf16*)(F.ws + T_BBT) + ((size_t)lg * 128 + 16 * nb + fr) * 16 + 8 * fq); }
#pragma unroll
    for (int ks = 0; ks < 4; ++ks) ctf[ks] = *(const GAS bf16x8*)((const bf16*)(F.ws + T_CT) + ((size_t)lg * 16 + fr) * 128 + 32 * ks + 8 * fq);
    const float ar = ((const GAS float*)(F.ws + T_S5A))[2 * (lg * 64 + lane)], ai = ((const GAS float*)(F.ws + T_S5A))[2 * (lg * 64 + lane) + 1];
    const float dsk = ((const GAS float*)F.in[19])[layer * 1024 + g * 16 + fr];
    bf16x8 dskf = zf;
#pragma unroll
    for (int j = 0; j < 8; ++j) if (fq < 2 && 8 * fq + j == fr) dskf[j] = (short)f2bf(dsk);
    float xr = 0.f, xi = 0.f;
    const bf16* up = proj + (size_t)lrow0 * NP + C_US + g * 16;
    bf16x8 ac[4], an[4];
#pragma unroll
    for (int k = 0; k < 4; ++k) { ac[k] = zf; an[k] = zf; if (fq < 2) ac[k] = *(const GAS bf16x8*)(up + (size_t)(16 * k + fr) * NP + 8 * fq); }
    for (int blk = 0; blk < L / 64; ++blk) {
        if (blk + 1 < L / 64) {
#pragma unroll
            for (int k = 0; k < 4; ++k) if (fq < 2) an[k] = *(const GAS bf16x8*)(up + (size_t)(64 * (blk + 1) + 16 * k + fr) * NP + 8 * fq); }
#pragma unroll
        for (int k = 0; k < 4; ++k) {
            const int t0 = 64 * blk + 16 * k; const bf16x8 a = ac[k];
#pragma unroll
            for (int nb = 0; nb < 8; ++nb) { const f32x4 acc = MFMA16(bbf[nb], a, ((f32x4){0.f, 0.f, 0.f, 0.f}));
                *(LAS f32x4*)(bu + fr * S5_BUP + 4 * (16 * nb + 4 * fq)) = acc; }
            LDS_WAIT();
            f32x2 b2[16];
#pragma unroll
            for (int t = 0; t < 16; ++t) b2[t] = *(const LAS f32x2*)(bu + t * S5_BUP + 8 * lane);
#pragma unroll
            for (int t = 0; t < 16; ++t) { const float nr = ar * xr - ai * xi + b2[t].x, ni = ar * xi + ai * xr + b2[t].y; xr = nr; xi = ni;
                *(LAS unsigned*)(xs + t * S5_XP + 4 * lane) = pk2(xr, xi); }
            LDS_WAIT();
            bf16x8 xa[4];
#pragma unroll
            for (int ks = 0; ks < 4; ++ks) xa[ks] = *(const LAS bf16x8*)(xs + fr * S5_XP + (32 * ks + 8 * fq) * 2);
            f32x4 y = MFMA16(dskf, a, ((f32x4){0.f, 0.f, 0.f, 0.f}));
#pragma unroll
            for (int ks = 0; ks < 4; ++ks) y = MFMA16(ctf[ks], xa[ks], y);
            *(GAS v2u*)(ys5 + (size_t)(lrow0 + t0 + fr) * 1024 + g * 16 + 4 * fq) = (v2u){pk2(gelu_tanh(y[0]), gelu_tanh(y[1])), pk2(gelu_tanh(y[2]), gelu_tanh(y[3]))};
            LDS_WAIT();
        }
#pragma unroll
        for (int k = 0; k < 4; ++k) ac[k] = an[k];
    }
}

DI void p4_post_norms(Frame& F, int layer) {
    const bf16* proj = (const bf16*)(F.ws + WS_PROJ); const bf16* hm = (const bf16*)(F.ws + WS_HM);
    bf16* Y = (bf16*)(F.ws + WS_Y);
    const int lane = F.lane;
    const float* gm = F.in[8] + layer * 1024;
    const int gw = F.bid * NWAVES + F.wave, NGW = F.G * NWAVES;
    f32x4 gg[4];
#pragma unroll
    for (int h = 0; h < 4; ++h) gg[h] = *(const GAS f32x4*)(gm + h * 256 + 4 * lane);
    v2u hv[4], ov[4], hn[4], on[4];
#define P4_LOAD(r_, H, O) do { _Pragma("unroll") for (int h = 0; h < 4; ++h) { const int c = h * 256 + 4 * lane; H[h] = *(const GAS v2u*)(hm + (size_t)(r_) * 1024 + c); O[h] = *(const GAS v2u*)(proj + (size_t)(r_) * NP + C_OM + c); } } while (0)
    if (gw < MC) P4_LOAD(gw, hv, ov);
    for (int r = gw; r < MC; r += NGW) {
        if (r + NGW < MC) P4_LOAD(r + NGW, hn, on);
#pragma unroll
        for (int h = 0; h < 4; ++h) { const int c = h * 256 + 4 * lane;
            const float v0 = bflo(hv[h].x), v1 = bfhi(hv[h].x), v2 = bflo(hv[h].y), v3 = bfhi(hv[h].y);
            const float rstd = 1.0f / sqrtf(wave_sum(v0 * v0 + v1 * v1 + v2 * v2 + v3 * v3) * (1.0f / 256.0f) + EPS);
            v2u o; o.x = pk2(sigm(bflo(ov[h].x)) * v0 * rstd * gg[h].x, sigm(bfhi(ov[h].x)) * v1 * rstd * gg[h].y); o.y = pk2(sigm(bflo(ov[h].y)) * v2 * rstd * gg[h].z, sigm(bfhi(ov[h].y)) * v3 * rstd * gg[h].w);
            *(GAS v2u*)(Y + (size_t)r * 1024 + c) = o; }
#pragma unroll
        for (int h = 0; h < 4; ++h) { hv[h] = hn[h]; ov[h] = on[h]; }
    }
#undef P4_LOAD
}

#ifndef RES_NO_NT
#define PR_ST(p_, v_) __builtin_nontemporal_store((v_), (p_))
#else
#define PR_ST(p_, v_) (*(p_) = (v_))
#endif
#ifndef RES_NO_NT_LD
#define PR_LD(p_) __builtin_nontemporal_load(p_)
#else
#define PR_LD(p_) (*(p_))
#endif
template <bool XIN_F32, bool XOUT_F32, int XN_I8 = 0>
DI void p_residual(Frame& F, int nrows, const bf16* ysrc, const void* xsrc_, void* out_, bf16* xn, const float* gpost, const float* gnext, float* sa = nullptr, unsigned char* xn8 = nullptr) {
    const int lane = F.lane, gw = F.bid * NWAVES + F.wave, NGW = F.G * NWAVES;
    const float* xsrc32 = (const float*)xsrc_; const bf16* xsrc16 = (const bf16*)xsrc_; float* out32 = (float*)out_; bf16* out16 = (bf16*)out_;
    f32x4 gp[8], gn[8];
#pragma unroll
    for (int j = 0; j < 8; ++j) { const int c = 4 * (lane + 64 * j); gp[j] = *(const GAS f32x4*)(gpost + c); gn[j] = gnext ? *(const GAS f32x4*)(gnext + c) : (f32x4){0.f, 0.f, 0.f, 0.f}; }
    constexpr bool DEEP = !XIN_F32;
    v2u yw[8], ywn[8], ywn2[DEEP ? 8 : 1]; f32x4 xv[XIN_F32 ? 8 : 1], xvn[XIN_F32 ? 8 : 1]; v2u xw[XIN_F32 ? 1 : 8], xwn[XIN_F32 ? 1 : 8], xwn2[XIN_F32 ? 1 : 8];
#define PR_LOAD(r_, YW, XV, XW) do { _Pragma("unroll") for (int j = 0; j < 8; ++j) { YW[j] = PR_LD((const GAS v2u*)(ysrc + (size_t)(r_) * D + 4 * (lane + 64 * j))); \
        if constexpr (XIN_F32) XV[j] = PR_LD((const GAS f32x4*)(xsrc32 + (size_t)(r_) * D + 4 * (lane + 64 * j))); \
        else XW[j] = PR_LD((const GAS v2u*)(xsrc16 + (size_t)(r_) * D + 4 * (lane + 64 * j))); } } while (0)
    if (gw < nrows) PR_LOAD(gw, yw, xv, xw);
    if constexpr (DEEP) { if (gw + NGW < nrows) PR_LOAD(gw + NGW, ywn, xvn, xwn); }
    for (int r = gw; r < nrows; r += NGW) { const size_t grow = (size_t)r;
        if constexpr (DEEP) { if (r + 2 * NGW < nrows) PR_LOAD(r + 2 * NGW, ywn2, xvn, xwn2); }
        else { if (r + NGW < nrows) PR_LOAD(r + NGW, ywn, xvn, xwn); }
        f32x4 y[8]; float s = 0.f;
#pragma unroll
        for (int j = 0; j < 8; ++j) { y[j] = (f32x4){bflo(yw[j].x), bfhi(yw[j].x), bflo(yw[j].y), bfhi(yw[j].y)}; s += (y[j].x * y[j].x + y[j].y * y[j].y) + (y[j].z * y[j].z + y[j].w * y[j].w); }
        const float rstd = 1.0f / sqrtf(wave_sum(s) * (1.0f / D) + EPS);
        float s2 = 0.f;
#pragma unroll
        for (int j = 0; j < 8; ++j) { f32x4 xin; if constexpr (XIN_F32) xin = xv[j]; else xin = (f32x4){bflo(xw[j].x), bfhi(xw[j].x), bflo(xw[j].y), bfhi(xw[j].y)};
            const f32x4 o = xin + y[j] * rstd * gp[j];
            if (XOUT_F32) PR_ST((GAS f32x4*)(out32 + grow * D + 4 * (lane + 64 * j)), o);
            else PR_ST((GAS v2u*)(out16 + grow * D + 4 * (lane + 64 * j)), ((v2u){pk2(o.x, o.y), pk2(o.z, o.w)}));
            y[j] = o;
            s2 += (o.x * o.x + o.y * o.y) + (o.z * o.z + o.w * o.w); }
        if (gnext) { const float rstd2 = 1.0f / sqrtf(wave_sum(s2) * (1.0f / D) + EPS);
#pragma unroll
            for (int j = 0; j < 8; ++j) y[j] = y[j] * rstd2 * gn[j];
            if (XN_I8) { float mx = 0.f; unsigned char* o8 = XN_I8 == 2 ? xn8 : (unsigned char*)xn;
#pragma unroll
                for (int j = 0; j < 8; ++j) mx = fmaxf(fmaxf(mx, fmaxf(fabsf(y[j].x), fabsf(y[j].y))), fmaxf(fabsf(y[j].z), fabsf(y[j].w)));
                mx = wave_max(mx); const float inv = mx > 0.f ? 127.0f / mx : 0.f;
#pragma unroll
                for (int j = 0; j < 8; ++j) PR_ST((GAS unsigned*)(o8 + grow * D + 4 * (lane + 64 * j)), pack_i8(y[j], inv));
                if (lane == 0) sa[grow] = mx * (1.0f / 127.0f);
            }
            if (XN_I8 != 1) {
#pragma unroll
                for (int j = 0; j < 8; ++j) { const f32x4 o = y[j];
                    PR_ST((GAS v2u*)(xn + grow * D + 4 * (lane + 64 * j)), ((v2u){pk2(o.x, o.y), pk2(o.z, o.w)})); } } }
#pragma unroll
        for (int j = 0; j < 8; ++j) { yw[j] = ywn[j]; if constexpr (XIN_F32) xv[j] = xvn[j]; else { xw[j] = xwn[j]; xwn[j] = xwn2[j]; ywn[j] = ywn2[j]; } }
    }
#undef PR_LOAD
}

DI void p9_fixup(Frame& F, int layer) {
    const bf16* raw = (const bf16*)(F.ws + WS_RAW); bf16* act = (bf16*)(F.ws + WS_ACT);

    const float* cw = F.in[24] + (size_t)layer * 3 * NUP; const float* cb = F.in[25] + (size_t)layer * NUP; const float* sbt = (const float*)(F.ws + T_SB_UP);
    const int gt = F.bid * NTHR + F.tid, NGT = F.G * NTHR;
    constexpr int NCG = DFF / 8;
    for (int task = gt; task < NCG * (MH / 64); task += NGT) {
        const int cg = task % NCG, blk = task / NCG, c = 8 * cg, t0 = (blk * 64) & (L - 1);
        const bf16* rb = raw + (size_t)blk * 4 * 2 * DFF + c;
        const bf16* rp = rb - (size_t)4 * 2 * DFF;
        v4u xa[4], xv[4];
#pragma unroll
        for (int k = 0; k < 2; ++k) { xa[k] = (v4u){0u, 0u, 0u, 0u}; xv[k] = xa[k];
            if (t0 > 0) { xa[k] = *(const GAS v4u*)(rp + (size_t)(2 + k) * 2 * DFF); xv[k] = *(const GAS v4u*)(rp + (size_t)(2 + k) * 2 * DFF + DFF); }
            xa[2 + k] = *(const GAS v4u*)(rb + (size_t)k * 2 * DFF); xv[2 + k] = *(const GAS v4u*)(rb + (size_t)k * 2 * DFF + DFF); }
#pragma unroll
        for (int r = 0; r < 2; ++r) {
            unsigned o[4];
#pragma unroll
            for (int k = 0; k < 4; ++k) { float res[2];
#pragma unroll
                for (int hh = 0; hh < 2; ++hh) { const int cc = c + 2 * k + hh;
                    const float a0 = hh ? bfhi(xa[r][k]) : bflo(xa[r][k]), a1 = hh ? bfhi(xa[r + 1][k]) : bflo(xa[r + 1][k]), a2 = hh ? bfhi(xa[r + 2][k]) : bflo(xa[r + 2][k]);
                    const float v0 = hh ? bfhi(xv[r][k]) : bflo(xv[r][k]), v1 = hh ? bfhi(xv[r + 1][k]) : bflo(xv[r + 1][k]), v2 = hh ? bfhi(xv[r + 2][k]) : bflo(xv[r + 2][k]);
                    const int ia_ = (cc >> 7) * 256 + (cc & 127);
                    const float qa = ((const GAS float*)sbt)[ia_], qv = ((const GAS float*)sbt)[ia_ + 128];
                    const GAS float* cwg = (const GAS float*)cw; const GAS float* cbg = (const GAS float*)cb;
                    const float ya = (cwg[cc] * a0 + cwg[NUP + cc] * a1 + cwg[2 * NUP + cc] * a2) * qa + cbg[cc];
                    const float yv = (cwg[DFF + cc] * v0 + cwg[NUP + DFF + cc] * v1 + cwg[2 * NUP + DFF + cc] * v2) * qv + cbg[DFF + cc];
                    res[hh] = gelu_tanh(ya) * yv; }
                o[k] = pk2(res[0], res[1]); }
            *(GAS v4u*)(act + (size_t)(blk * 64 + r) * DFF + c) = (v4u){o[0], o[1], o[2], o[3]};
        }
    }
}
#define XB_TMO      128
#define XB_XCNT(j)  (256  + 64 * (j))
#define XB_XSUB(j)  (1280 + 64 * (j))
#define XB_XGEN(j)  (2304 + 64 * (j))
#define XB_TOP      3328
#define XB_TOPGEN   3392
#define XCD_BAR_WORDS 3456
#define XB_SPIN_CAP (1u << 18)

__device__ __forceinline__ unsigned xb_ld(unsigned* p)              { return __hip_atomic_load(p, __ATOMIC_RELAXED, __HIP_MEMORY_SCOPE_AGENT); }
__device__ __forceinline__ unsigned xb_add(unsigned* p, unsigned v) { return __hip_atomic_fetch_add(p, v, __ATOMIC_RELAXED, __HIP_MEMORY_SCOPE_AGENT); }
__device__ __forceinline__ unsigned xb_xcc_id() { return (unsigned)__builtin_amdgcn_s_getreg((3 << 11) | 20) & 0xFu; }
#define XB_SPIN(cond, bar) do { unsigned _sp = 0; while (cond) { __builtin_amdgcn_s_sleep(1); \
    if ((++_sp & 255u) == 0u) { if (xb_ld(&(bar)[XB_TMO])) break; if (_sp > XB_SPIN_CAP) { atomicAdd(&(bar)[XB_TMO], 1u); break; } } } } while (0)

struct XcdBarrier {
    unsigned* bar; unsigned x;
    volatile LAS unsigned* st;
};

__device__ __forceinline__ XcdBarrier xcd_barrier_post(unsigned* bar, volatile LAS unsigned* st) {
    XcdBarrier b; b.bar = bar; b.x = xb_xcc_id(); b.st = st;
    if (threadIdx.x == 0) (void)xb_add(&bar[XB_XCNT(b.x)], 1u);
    return b;
}
__device__ __forceinline__ void xcd_barrier_complete(unsigned* bar, unsigned x, unsigned& nloc, unsigned& nx) {
    const unsigned G = gridDim.x * gridDim.y * gridDim.z;
    unsigned sum, cnt, mine, sp = 0u;
    for (;;) {
        sum = 0u; cnt = 0u; mine = 0u;
#pragma unroll
        for (unsigned j = 0; j < 16; ++j) { const unsigned c = xb_ld(&bar[XB_XCNT(j)]); sum += c; cnt += (c > 0u) ? 1u : 0u; mine = (j == x) ? c : mine; }
        if (sum == G) break;
        __builtin_amdgcn_s_sleep(1);
        if ((++sp & 255u) == 0u) { if (xb_ld(&bar[XB_TMO])) break; if (sp > XB_SPIN_CAP) { atomicAdd(&bar[XB_TMO], 1u); break; } }
    }
    nloc = mine > 0u ? mine : 1u; nx = cnt > 0u ? cnt : 1u;
}

__device__ __forceinline__ void xcd_barrier(const XcdBarrier& b) {
    asm volatile("s_waitcnt vmcnt(0)" ::: "memory");
    __syncthreads();
    if (threadIdx.x == 0) {
        unsigned* bar = b.bar;
        __builtin_amdgcn_s_waitcnt(0);
        unsigned nloc = b.st[0], nx = b.st[1];
        if (nloc == 0u) { xcd_barrier_complete(bar, b.x, nloc, nx); b.st[0] = nloc; b.st[1] = nx; }
        const unsigned old = xb_add(&bar[XB_XSUB(b.x)], 1u);
        const unsigned gen = old / nloc;
        if (old + 1u == (gen + 1u) * nloc) {
            __builtin_amdgcn_fence(__ATOMIC_RELEASE, "agent");
            asm volatile("s_waitcnt vmcnt(0)" ::: "memory");
            const unsigned og = xb_add(&bar[XB_TOP], 1u);
            const unsigned tg = og / nx;
            if (og + 1u == (tg + 1u) * nx) xb_add(&bar[XB_TOPGEN], 1u);
            else XB_SPIN(xb_ld(&bar[XB_TOPGEN]) == tg, bar);
            __builtin_amdgcn_fence(__ATOMIC_ACQUIRE, "agent");
            xb_add(&bar[XB_XGEN(b.x)], 1u);
            asm volatile("s_waitcnt vmcnt(0)" ::: "memory");
        } else {
            XB_SPIN(xb_ld(&bar[XB_XGEN(b.x)]) == gen, bar);
            __builtin_amdgcn_fence(__ATOMIC_ACQUIRE, "agent");
            asm volatile("s_waitcnt vmcnt(0)" ::: "memory");
        }
    }
    __syncthreads();
}

struct Args { const float* in[27]; float* out; unsigned char* ws; int lc_lo, lc_hi, ph_lo, ph_hi, use_bar, pad; };
constexpr int N_ITEMS_ML = 64, N_ITEMS_S5 = 32, N_ITEMS_AT = 512, N_ITEMS = N_ITEMS_ML + N_ITEMS_S5 + N_ITEMS_AT;

__global__ void __launch_bounds__(NTHR, 2) fwd_kernel(Args args) {
    extern __shared__ __attribute__((aligned(16))) unsigned char lds_raw[];
    Frame F;
    F.lds = (LAS unsigned char*)lds_raw;
    F.MISC = (volatile LAS unsigned*)(F.lds + LDSCTL_OFF);
    F.tid = threadIdx.x; F.lane = F.tid & 63; F.wave = __builtin_amdgcn_readfirstlane(F.tid >> 6);
    F.G = gridDim.x; F.bid = blockIdx.x;
    F.ws = args.ws; F.ctl = (gu32*)(args.ws + WS_CTL); F.out = args.out;
    F.in = args.in;
    for (int u = F.tid; u < (LDS_BYTES - LDSCTL_OFF) / 4; u += NTHR) ((LAS unsigned*)(F.lds + LDSCTL_OFF))[u] = 0u;
    __syncthreads();
    XcdBarrier bar; bar.bar = (unsigned*)(F.ctl + CW_BAR); bar.x = 0; bar.st = nullptr;
    if (args.use_bar) bar = xcd_barrier_post((unsigned*)(F.ctl + CW_BAR), F.MISC + 8);
#ifdef DBG_DOUBLE_BAR
#define GRID_BAR() do { if (args.use_bar) { xcd_barrier(bar); xcd_barrier(bar); } } while (0)
#else
#define GRID_BAR() do { if (args.use_bar) { unsigned* b_ = (unsigned*)(args.ws + WS_CTL) + CW_BAR; asm volatile("" : "+s"(b_)); bar.bar = b_; xcd_barrier(bar); } } while (0)
#endif
    const int lo = args.ph_lo, hi = args.ph_hi;
#ifndef PH_MASK
#define PH_MASK 0xFFF
#endif
#ifndef GEMM_ALIGN
#define GEMM_ALIGN true
#endif
#ifndef GEMM_SP2
#define GEMM_SP2 true
#endif
#ifndef DBG_REPEAT
#define DBG_REPEAT -1
#endif
#ifndef DBG_STORE_MOD
#define DBG_STORE_MOD 1000000
#endif
#define REP(k) ((k) == DBG_REPEAT ? 2 : 1)
#define IN(k) (((PH_MASK >> (k)) & 1) && lo <= (k) && (k) < hi)
#define RELAUNDER() do { int t_ = threadIdx.x; asm volatile("" : "+v"(t_)); F.tid = t_; F.lane = t_ & 63; F.wave = __builtin_amdgcn_readfirstlane(t_ >> 6); \
        unsigned char* w_ = args.ws; asm volatile("" : "+s"(w_)); F.ws = w_; F.ctl = (gu32*)(w_ + WS_CTL); float* o_ = args.out; asm volatile("" : "+s"(o_)); F.out = o_; } while (0)

    for (int layer = 0; layer < DEPTH; ++layer) {
        for (int rep = 0; rep < REP(0); ++rep) if (IN(0)) { RELAUNDER(); p0_weights(F, layer); if (layer == 0) p0_tables(F); __syncthreads(); GRID_BAR(); }

        for (int chunk = 0; chunk < NCH; ++chunk) {
            const int lc = layer * NCH + chunk;
            for (int rep = 0; rep < REP(1); ++rep) if (IN(1)) { RELAUNDER();
                { pg8::Gemm g{(const bf16*)(F.ws + WS_XN) + (size_t)chunk * MC * D, (const bf16*)(F.ws + WS_WIN), MC, 4096, D, nullptr};
                  pg8::StaticOrder S; S.init(MC, 4096, F.G, F.bid);
                  pg8::EpiBf16 E{(bf16*)(F.ws + WS_PROJ), NP, 0, 1 << 30, 8, 2048};
                  pg8::gemm_phase<pg8::EpiBf16, pg8::StaticOrder, GEMM_ALIGN, GEMM_SP2>(F.lds, g, S, E); }
                RELAUNDER();
                { pg8::Gemm g{(const bf16*)(F.ws + WS_XN8M + (size_t)chunk * MC * D), (const bf16*)(F.ws + WS_WG8), MC, NI8, D, nullptr};
                  pg8::StaticOrder S; S.init(MC, NI8, F.G, F.bid);
                  pg8::EpiGateI8 E{(bf16*)(F.ws + WS_PROJ), NP, C_GATE, (const float*)(F.ws + T_SA_MIX) + (size_t)chunk * MC, (const float*)(F.ws + T_SB_G), F.lds + 131072};
                  pg8::gemm_phase<pg8::EpiGateI8, pg8::StaticOrder, GEMM_ALIGN, GEMM_SP2, true>(F.lds, g, S, E); }
                GRID_BAR();
            }
            for (int rep = 0; rep < REP(2); ++rep) if (IN(2)) { RELAUNDER(); p2_conv_gates(F, layer, chunk); GRID_BAR(); }

            for (int rep3 = 0; rep3 < REP(3); ++rep3) if (IN(3)) {
                for (;;) { RELAUNDER();
                    const int xq = F.bid & 7;
                    if (F.tid == 0) F.MISC[0] = __hip_atomic_fetch_add(F.ctl + CW_QUEUE + 64 * (lc + 8 * rep3) + 8 * xq, 1u, RLX_AGENT);
                    __syncthreads();
                    const int qpos = __builtin_amdgcn_readfirstlane((int)F.MISC[0]);
                    __syncthreads();
                    if (qpos >= N_ITEMS / 8) break;
                    int item;
                    if (qpos < N_ITEMS_ML / 8) item = (N_ITEMS_ML / 8) * xq + qpos;
                    else if (qpos < (N_ITEMS_ML + N_ITEMS_S5) / 8) item = N_ITEMS_ML + (N_ITEMS_S5 / 8) * xq + (qpos - N_ITEMS_ML / 8);
                    else { const int a = qpos - (N_ITEMS_ML + N_ITEMS_S5) / 8; item = N_ITEMS_ML + N_ITEMS_S5 + ((a >> 1) << 4) + 2 * xq + (a & 1); }
#ifndef IT_MASK
#define IT_MASK 7
#endif
#ifndef DBG_REP_ITEMS
#define DBG_REP_ITEMS 7
#endif
                    const int itm = rep3 ? (IT_MASK & DBG_REP_ITEMS) : IT_MASK;
                    if (item < N_ITEMS_ML) { if (itm & 1) mlstm_item(F, chunk, item); }
                    else if (item < N_ITEMS_ML + N_ITEMS_S5) { if (itm & 2) s5_item(F, layer, item - N_ITEMS_ML); }
                    else { if (itm & 4) attn_item(F, layer, item - N_ITEMS_ML - N_ITEMS_S5); }
                    __syncthreads();
                }
                GRID_BAR();
            }
            for (int rep = 0; rep < REP(4); ++rep) if (IN(4)) { RELAUNDER();
                pg8::Gemm g{(const bf16*)(F.ws + WS_YS5), (const bf16*)(F.ws + WS_WGLU), MC, 2048, 1024, nullptr};
                pg8::StaticOrder S; S.init(MC, 2048, F.G, F.bid);
                pg8::EpiGlu E{(bf16*)(F.ws + WS_Y) + (size_t)2 * MC * 1024, 1024};
                pg8::gemm_phase<pg8::EpiGlu, pg8::StaticOrder, true, GEMM_SP2>(F.lds, g, S, E);
                p4_post_norms(F, layer);
                GRID_BAR();
            }
            for (int rep = 0; rep < REP(5); ++rep) if (IN(5)) { RELAUNDER();
                pg8::Gemm g{(const bf16*)(F.ws + WS_Y), (const bf16*)(F.ws + WS_WB), 3 * MC, 3 * 2048, 1024, nullptr};
                pg8::BranchOrder S; S.init(F.G, F.bid);
                pg8::EpiBranch E{(const bf16*)(F.ws + WS_PROJ), NP, C_GATE, (bf16*)(F.ws + WS_MERGED) + (size_t)chunk * MC * D, (const bf16*)(F.ws + T_ONES)};
                pg8::gemm_phase<pg8::EpiBranch, pg8::BranchOrder, true, GEMM_SP2>(F.lds, g, S, E);
                GRID_BAR();
            }
        }
        for (int rep = 0; rep < REP(6); ++rep) if (IN(6)) { RELAUNDER();
            pg8::Gemm g{(const bf16*)(F.ws + WS_MERGED), (const bf16*)(F.ws + WS_WOUT), M, D, D, nullptr};
            pg8::StaticOrder S; S.init(M, D, F.G, F.bid);
            pg8::EpiBf16 E{(bf16*)(F.ws + WS_MIX), D, 0, 1 << 30, 1 << 30, 0};
            pg8::gemm_phase<pg8::EpiBf16, pg8::StaticOrder, GEMM_ALIGN, GEMM_SP2>(F.lds, g, S, E);
            GRID_BAR();
        }
        for (int rep = 0; rep < (layer == 0 ? REP(7) : 1); ++rep) if (IN(7)) { RELAUNDER();
            if (layer == 0) p_residual<true, false, 1>(F, M, (const bf16*)(F.ws + WS_MIX), F.in[0], F.ws + WS_XB, (bf16*)(F.ws + WS_XN8F), F.in[2] + layer * D, F.in[3] + layer * D, (float*)(F.ws + T_SA_FFN));
            else p_residual<false, false, 1>(F, M, (const bf16*)(F.ws + WS_MIX), F.ws + WS_XB, F.ws + WS_XB, (bf16*)(F.ws + WS_XN8F), F.in[2] + layer * D, F.in[3] + layer * D, (float*)(F.ws + T_SA_FFN));
            GRID_BAR();
        }
        for (int half = 0; half < M / MH; ++half) {
            for (int rep = 0; rep < REP(8); ++rep) if (IN(8)) { RELAUNDER();
                pg8::Gemm g{(const bf16*)(F.ws + WS_XN8F + (size_t)half * MH * D), (const bf16*)(F.ws + WS_WUP), MH, NUP, D, nullptr};
                pg8::GemmOrder S; S.init(MH, NUP, F.G, F.bid, D / 64);
                pg8::EpiUpConv<true> E{(bf16*)(F.ws + WS_ACT), (bf16*)(F.ws + WS_RAW), F.in[24] + (size_t)layer * 3 * NUP, F.in[25] + (size_t)layer * NUP, DFF, NUP, (const float*)(F.ws + T_SA_FFN) + (size_t)half * MH, (const float*)(F.ws + T_SB_UP)
                };
                pg8::gemm_phase<pg8::EpiUpConv<true>, pg8::GemmOrder, GEMM_ALIGN, GEMM_SP2, true>(F.lds, g, S, E);
                GRID_BAR();
            }
            for (int rep = 0; rep < REP(9); ++rep) if (IN(9)) { RELAUNDER(); p9_fixup(F, layer); GRID_BAR(); }
            for (int rep = 0; rep < REP(10); ++rep) if (IN(10)) { RELAUNDER();
                pg8::Gemm g{(const bf16*)(F.ws + WS_ACT), (const bf16*)(F.ws + WS_WDN), MH, D, DFF, nullptr};
                pg8::StaticOrder S; S.init(MH, D, F.G, F.bid);
                pg8::EpiBf16 E{(bf16*)(F.ws + WS_FFN), D, 0, 1 << 30, 1 << 30, 0};
                pg8::gemm_phase<pg8::EpiBf16, pg8::StaticOrder, GEMM_ALIGN, GEMM_SP2>(F.lds, g, S, E);
                GRID_BAR();
            }
            if (IN(11)) { RELAUNDER();
                const size_t ro = (size_t)half * MH * D;
                if (layer + 1 < DEPTH) p_residual<false, false, 2>(F, MH, (const bf16*)(F.ws + WS_FFN), (const bf16*)(F.ws + WS_XB) + ro, (bf16*)(F.ws + WS_XB) + ro, (bf16*)(F.ws + WS_XN) + ro, F.in[4] + layer * D, F.in[1] + (layer + 1) * D,
                                                                      (float*)(F.ws + T_SA_MIX) + (size_t)half * MH, F.ws + WS_XN8M + ro);
                else p_residual<false, true>(F, MH, (const bf16*)(F.ws + WS_FFN), (const bf16*)(F.ws + WS_XB) + ro, F.out + ro, nullptr, F.in[4] + layer * D, nullptr);
                GRID_BAR();
            }
        }
    }
#undef IN
#undef GRID_BAR
}


#ifdef DBG_DUMP
__global__ void dbg_dump(const unsigned char* ws, float* out, size_t off, size_t nelem, int is_f32) {
    for (size_t i = (size_t)blockIdx.x * blockDim.x + threadIdx.x; i < (size_t)M * D; i += (size_t)gridDim.x * blockDim.x) {
        const size_t j = i % nelem; out[i] = is_f32 ? ((const float*)(ws + off))[j] : __uint_as_float(((unsigned)((const unsigned short*)(ws + off))[j]) << 16); }
}
#endif

#ifndef MK_SINGLE
#define MK_SINGLE 1
#endif
extern "C" void kernel_launch(void* const* d_in, const int* in_sizes, int n_in, void* d_out, int out_size, void* d_ws, size_t ws_size, hipStream_t stream) {
    static int grid = 0;
    if (grid == 0) {
        if (n_in != 27 || in_sizes[0] != M * D || out_size != M * D || ws_size < WS_END) { fprintf(stderr, "kernel_launch: unexpected shapes (n_in %d, in0 %d, out %d, ws %zu)\n", n_in, n_in > 0 ? in_sizes[0] : -1, out_size, ws_size); grid = -1; return; }
        int dev = 0, cus = 0, per_cu = 0;
        if (hipGetDevice(&dev) != hipSuccess || hipDeviceGetAttribute(&cus, hipDeviceAttributeMultiprocessorCount, dev) != hipSuccess) { grid = -1; return; }
        if (hipFuncSetAttribute((const void*)fwd_kernel, hipFuncAttributeMaxDynamicSharedMemorySize, LDS_BYTES) != hipSuccess) { grid = -1; return; }
        if (hipOccupancyMaxActiveBlocksPerMultiprocessor(&per_cu, (const void*)fwd_kernel, NTHR, LDS_BYTES) != hipSuccess || per_cu < 1) { fprintf(stderr, "kernel_launch: occupancy query says %d\n", per_cu); }
        (void)hipGetLastError();
        grid = cus;
    }
    if (grid < 0) return;
    if (hipMemsetAsync((char*)d_ws + WS_CTL, 0, CTL_ZERO_BYTES, stream) != hipSuccess) return;
    Args a{};
    for (int i = 0; i < 27; ++i) a.in[i] = (const float*)d_in[i];
    a.out = (float*)d_out; a.ws = (unsigned char*)d_ws; a.pad = 0;
    a.lc_lo = 0; a.lc_hi = DEPTH * NCH; a.ph_lo = 0; a.ph_hi = 12; a.use_bar = 1;
    hipLaunchKernelGGL(fwd_kernel, dim3(grid), dim3(NTHR), LDS_BYTES, stream, a);
}
```
